# Optimizing an MI355X kernel written in HIP

```python
import jax, jax.numpy as jnp
from jax import lax
import numpy as np

D_MODEL = 1024
BATCH = 16
SEQ = 2048
DEPTH = 1

GRID_W = 64
HEAD_DIM = 64
N_Q_HEADS = 8
N_KV_HEADS = 2
Q_PER_KV = N_Q_HEADS // N_KV_HEADS
ATTN_WIDTH = N_Q_HEADS * HEAD_DIM
KV_WIDTH = N_KV_HEADS * HEAD_DIM
LRU_WIDTH = D_MODEL - ATTN_WIDTH
LRU_BLOCKS = 8
LRU_BLOCK = LRU_WIDTH // LRU_BLOCKS
CONV_WIDTH = 4
LRU_C = 8.0
D_MIX = ATTN_WIDTH + LRU_WIDTH
D_IN = ATTN_WIDTH + 2 * KV_WIDTH + 2 * LRU_WIDTH
D_FF = -(-8 * D_MODEL // (3 * 256)) * 256
Q_BLOCK = 128
ROPE_THETA = 10000.0
EPS = 1e-6

kernel_name = "hymba_attn_rglru_hybrid_encoder"


def rms_norm(x, g):
    x32 = x.astype(jnp.float32)
    y = x32 * lax.rsqrt(jnp.mean(x32 * x32, axis=-1, keepdims=True) + EPS)
    return (y * g.astype(jnp.float32)).astype(x.dtype)


def axial_rope_tables(S):
    rows = S // GRID_W
    row = jnp.repeat(jnp.arange(rows, dtype=jnp.float32), GRID_W)
    col = jnp.tile(jnp.arange(GRID_W, dtype=jnp.float32), rows)
    axis_dim = HEAD_DIM // 2
    inv = ROPE_THETA ** (-jnp.arange(0, axis_dim, 2, dtype=jnp.float32) / axis_dim)
    ang_r = row[:, None] * inv[None, :]
    ang_c = col[:, None] * inv[None, :]
    ang = jnp.concatenate([ang_r, ang_r, ang_c, ang_c], axis=-1)
    return jnp.cos(ang), jnp.sin(ang)


def _rotate_half(z):
    z1, z2 = jnp.split(z, 2, axis=-1)
    return jnp.concatenate([-z2, z1], axis=-1)


def apply_axial_rope(x, cos, sin):
    x32 = x.astype(jnp.float32)
    xr, xc = jnp.split(x32, 2, axis=-1)
    rot = jnp.concatenate([_rotate_half(xr), _rotate_half(xc)], axis=-1)
    out = x32 * cos[None, :, None, :] + rot * sin[None, :, None, :]
    return out.astype(x.dtype)


def block_attention(q, k, v):
    B, S = q.shape[0], q.shape[1]
    nblk = S // Q_BLOCK
    qb = q.reshape(B, nblk, Q_BLOCK, N_KV_HEADS, Q_PER_KV, HEAD_DIM).transpose(1, 0, 3, 4, 2, 5)
    kt = k.transpose(0, 2, 1, 3)
    vt = v.transpose(0, 2, 1, 3)
    scale = HEAD_DIM ** -0.5

    def one_block(qblk):
        s = jnp.einsum('bkgqd,bksd->bkgqs', qblk, kt,
                       preferred_element_type=jnp.float32) * scale
        p = jax.nn.softmax(s, axis=-1).astype(vt.dtype)
        return jnp.einsum('bkgqs,bksd->bkgqd', p, vt)

    ob = lax.map(one_block, qb)
    return ob.transpose(1, 0, 4, 2, 3, 5).reshape(B, S, ATTN_WIDTH)


def centred_depthwise_conv(x, w, b):
    S = x.shape[1]
    left = (CONV_WIDTH - 1) // 2
    xp = jnp.pad(x, ((0, 0), (left, CONV_WIDTH - 1 - left), (0, 0)))
    out = b[None, None, :]
    for j in range(CONV_WIDTH):
        out = out + xp[:, j:j + S, :] * w[j][None, None, :]
    return out


def _linear_combine(c1, c2):
    a1, b1 = c1
    a2, b2 = c2
    return a1 * a2, a2 * b1 + b2


def rg_lru_direction(x, w_r, b_r, w_i, b_i, lam, reverse):
    B, S, W = x.shape
    xb = x.reshape(B, S, LRU_BLOCKS, LRU_BLOCK)
    r = jax.nn.sigmoid(jnp.einsum('bsnc,ncd->bsnd', xb, w_r.astype(jnp.float32)).reshape(B, S, W)
                       + b_r.astype(jnp.float32))
    i = jax.nn.sigmoid(jnp.einsum('bsnc,ncd->bsnd', xb, w_i.astype(jnp.float32)).reshape(B, S, W)
                       + b_i.astype(jnp.float32))
    log_a = -LRU_C * r * jax.nn.softplus(-lam.astype(jnp.float32))
    a = jnp.exp(log_a)
    inp = jnp.sqrt(-jnp.expm1(2.0 * log_a)) * (i * x)
    _, h = lax.associative_scan(_linear_combine, (a, inp), reverse=reverse, axis=1)
    return h


def setup_inputs(seed: int = 0) -> dict:
    key = jax.random.key(seed)
    ks = jax.random.split(key, 24)
    f32 = jnp.float32

    def nrm(k, shape, fan_in, extra=1.0):
        return jax.random.normal(k, shape, f32) * (fan_in ** -0.5) * extra

    def gain(k, shape):
        return 1.0 + 0.02 * jax.random.normal(k, shape, f32)

    def bias(k, shape):
        return 0.02 * jax.random.normal(k, shape, f32)

    res_scale = (2.0 * DEPTH) ** -0.5
    x = jax.random.normal(ks[0], (BATCH, SEQ, D_MODEL), f32)
    norm_mix = gain(ks[1], (DEPTH, D_MODEL))
    w_in = nrm(ks[2], (DEPTH, D_MODEL, D_IN), D_MODEL)
    q_norm = gain(ks[3], (DEPTH, HEAD_DIM))
    k_norm = gain(ks[4], (DEPTH, HEAD_DIM))
    conv_w = nrm(ks[5], (DEPTH, CONV_WIDTH, LRU_WIDTH), CONV_WIDTH)
    conv_b = bias(ks[6], (DEPTH, LRU_WIDTH))
    w_rgate = nrm(ks[7], (DEPTH, 2, LRU_BLOCKS, LRU_BLOCK, LRU_BLOCK), LRU_BLOCK)
    b_rgate = bias(ks[8], (DEPTH, 2, LRU_WIDTH))
    w_igate = nrm(ks[9], (DEPTH, 2, LRU_BLOCKS, LRU_BLOCK, LRU_BLOCK), LRU_BLOCK)
    b_igate = bias(ks[10], (DEPTH, 2, LRU_WIDTH))
    a_pow_c = jax.random.uniform(ks[11], (DEPTH, 2, LRU_WIDTH), f32, 0.9, 0.999)
    a_base = a_pow_c ** (1.0 / LRU_C)
    lru_lambda = jnp.log(a_base) - jnp.log1p(-a_base)
    out_norm_attn = gain(ks[12], (DEPTH, ATTN_WIDTH))
    out_norm_lru = gain(ks[13], (DEPTH, LRU_WIDTH))
    w_out = nrm(ks[14], (DEPTH, D_MIX, D_MODEL), D_MIX, res_scale)
    norm_ffn = gain(ks[15], (DEPTH, D_MODEL))
    w_gate = nrm(ks[16], (DEPTH, D_MODEL, D_FF), D_MODEL)
    w_up = nrm(ks[17], (DEPTH, D_MODEL, D_FF), D_MODEL)
    w_down = nrm(ks[18], (DEPTH, D_FF, D_MODEL), D_FF, res_scale)
    return {"x": x, "norm_mix": norm_mix, "w_in": w_in, "q_norm": q_norm, "k_norm": k_norm,
            "conv_w": conv_w, "conv_b": conv_b, "w_rgate": w_rgate, "b_rgate": b_rgate,
            "w_igate": w_igate, "b_igate": b_igate, "lru_lambda": lru_lambda,
            "out_norm_attn": out_norm_attn, "out_norm_lru": out_norm_lru, "w_out": w_out,
            "norm_ffn": norm_ffn, "w_gate": w_gate, "w_up": w_up, "w_down": w_down}


def reference(x, norm_mix, w_in, q_norm, k_norm, conv_w, conv_b, w_rgate, b_rgate,
              w_igate, b_igate, lru_lambda, out_norm_attn, out_norm_lru, w_out,
              norm_ffn, w_gate, w_up, w_down):
    B, S, _ = x.shape
    cos, sin = axial_rope_tables(S)
    splits = [ATTN_WIDTH, ATTN_WIDTH + KV_WIDTH, ATTN_WIDTH + 2 * KV_WIDTH,
              ATTN_WIDTH + 2 * KV_WIDTH + LRU_WIDTH]
    h = x
    for l in range(DEPTH):
        u = rms_norm(h, norm_mix[l])
        proj = jnp.einsum('bsd,de->bse', u, w_in[l])
        q, k, v, xl, gl = jnp.split(proj, splits, axis=-1)
        q = q.reshape(B, S, N_Q_HEADS, HEAD_DIM)
        k = k.reshape(B, S, N_KV_HEADS, HEAD_DIM)
        v = v.reshape(B, S, N_KV_HEADS, HEAD_DIM)
        q = apply_axial_rope(rms_norm(q, q_norm[l]), cos, sin)
        k = apply_axial_rope(rms_norm(k, k_norm[l]), cos, sin)
        attn_out = block_attention(q, k, v)

        xc = centred_depthwise_conv(xl, conv_w[l], conv_b[l]).astype(jnp.float32)
        y_fwd = rg_lru_direction(xc, w_rgate[l, 0], b_rgate[l, 0], w_igate[l, 0],
                                 b_igate[l, 0], lru_lambda[l, 0], reverse=False)
        y_bwd = rg_lru_direction(xc, w_rgate[l, 1], b_rgate[l, 1], w_igate[l, 1],
                                 b_igate[l, 1], lru_lambda[l, 1], reverse=True)
        lru_out = ((y_fwd + y_bwd) * jax.nn.gelu(gl.astype(jnp.float32))).astype(h.dtype)

        mixed = jnp.concatenate([rms_norm(attn_out, out_norm_attn[l]),
                                 rms_norm(lru_out, out_norm_lru[l])], axis=-1)
        h = h + jnp.einsum('bse,ed->bsd', mixed, w_out[l])

        u = rms_norm(h, norm_ffn[l])
        ff = jax.nn.silu(jnp.einsum('bsd,df->bsf', u, w_gate[l])) * jnp.einsum('bsd,df->bsf', u, w_up[l])
        h = h + jnp.einsum('bsf,fd->bsd', ff, w_down[l])
    return h
```

```cpp
#include <hip/hip_runtime.h>
#include <hip/hip_cooperative_groups.h>
#include <cstdio>
#include <cstdint>
namespace pg8 {
#define PG8_LAS __attribute__((address_space(3)))
typedef unsigned short bf16_t;
typedef short bf16x8 __attribute__((ext_vector_type(8)));
typedef float f32x4 __attribute__((ext_vector_type(4)));
typedef unsigned u32x4 __attribute__((ext_vector_type(4)));
constexpr int BM = 256, BK = 64, HALF = 128, HTB = HALF * BK * 2  , STAGE_BYTES = 8 * HTB, NXCD = 8, WGM = 8;

__host__ __device__ __forceinline__ int lds_byte(int r, int c) { const int st = (r >> 4) * 2 + (c >> 5), rr = r & 15, cc = c & 31, ob = rr * 64 + cc * 2; return st * 1024 + (ob ^ (((ob >> 9) & 1) << 5)); }
__host__ __device__ __forceinline__ void stage_rc(int b, int& R, int& C) { const int st = b / 1024, sb = b % 1024, swz = sb ^ (((sb >> 9) & 1) << 5); R = (st >> 1) * 16 + swz / 64; C = (st & 1) * 32 + (swz % 64) / 2; }
__host__ __device__ __forceinline__ int perm32(int rho) { const int n = rho >> 4, i = rho & 15; return 8 * (i >> 2) + 4 * n + (i & 3); }

struct Unit { int pm, pn; };
struct Gemm { const bf16_t* A; const bf16_t* Bt; int M, N, K; };

struct StaticOrder {
    int nM, nN, nwg, G, c;
    __host__ __device__ void init(int M, int N, int G_, int c_) { nM = M / BM; nN = N / BM; nwg = nM * nN; G = G_; c = c_; }
    __host__ __device__ bool next(int i, Unit& u) const {
        const long L = (long)i * G + c; if (L >= nwg) return false;
        int wgid = (int)L; { const int q = nwg / NXCD, r = nwg % NXCD, xcd = wgid % NXCD, off = wgid / NXCD; wgid = (xcd < r ? xcd * (q + 1) : r * (q + 1) + (xcd - r) * q) + off; }
        const int nig = WGM * nN, gid = wgid / nig, fm = gid * WGM, gsz = (nM - fm) < WGM ? (nM - fm) : WGM;
        u.pm = fm + ((wgid % nig) % gsz); u.pn = (wgid % nig) / gsz; return true;
    }
    __device__ __forceinline__ void a_ready(const Unit&) const {}
    __device__ __forceinline__ void done(const Unit&) const {}
};

__device__ __forceinline__ unsigned cvt_pk_bf16(float lo, float hi) { unsigned r; asm volatile("v_cvt_pk_bf16_f32 %0, %1, %2" : "=v"(r) : "v"(lo), "v"(hi)); return r; }
typedef float f32x2 __attribute__((ext_vector_type(2)));
struct EpiStoreBf16 {
    __device__ __forceinline__ void prefetch(const Unit&, int, int) const {}
    __device__ __forceinline__ void rotate() const {}
    static constexpr bool PERM = true, AFTER_DRAIN = false;
    bf16_t* O; int ldc;
    __device__ __forceinline__ void operator()(const f32x4 (&acc)[2][2][4][2], const Unit& u, int wr, int wc, int fr, int fq) const {
        const int row0 = u.pm * BM + wr * 64 + fr, col0 = u.pn * BM + wc * 32 + 8 * fq;
#pragma unroll
        for (int ai = 0; ai < 2; ++ai)
#pragma unroll
            for (int m = 0; m < 4; ++m) { bf16_t* rowp = O + (size_t)(row0 + ai * HALF + m * 16) * ldc + col0;
#pragma unroll
                for (int bj = 0; bj < 2; ++bj) { const f32x4 v0 = acc[ai][bj][m][0], v1 = acc[ai][bj][m][1];
                    u32x4 w; w.x = cvt_pk_bf16(v0[0], v0[1]); w.y = cvt_pk_bf16(v0[2], v0[3]); w.z = cvt_pk_bf16(v1[0], v1[1]); w.w = cvt_pk_bf16(v1[2], v1[3]);
                    *(u32x4*)(rowp + bj * HALF) = w; } }
    }
};
struct EpiOutRes {
    static constexpr bool PERM = true, AFTER_DRAIN = false;
    const float* X; float* OUT; bf16_t* HB; float* ssq; float sscale; const float* ssqa; float eps; mutable float pre[2][4], nxv[2][4];
    __device__ __forceinline__ void rotate() const {
#pragma unroll
        for (int ai = 0; ai < 2; ++ai)
#pragma unroll
            for (int m = 0; m < 4; ++m) pre[ai][m] = nxv[ai][m];
    }
    __device__ __forceinline__ void prefetch(const Unit& u, int wr, int fr) const {
        const int row0 = u.pm * BM + wr * 64 + fr;
#pragma unroll
        for (int ai = 0; ai < 2; ++ai)
#pragma unroll
            for (int m = 0; m < 4; ++m) nxv[ai][m] = ssqa[row0 + ai * HALF + m * 16];
    }
    __device__ __forceinline__ void operator()(const f32x4 (&acc)[2][2][4][2], const Unit& u, int wr, int wc, int fr, int fq) const {
        const int row0 = u.pm * BM + wr * 64 + fr, col0 = u.pn * BM + wc * 32 + 8 * fq;
#pragma unroll
        for (int ai = 0; ai < 2; ++ai)
#pragma unroll
            for (int m = 0; m < 4; ++m) { const int row = row0 + ai * HALF + m * 16; const size_t off = (size_t)row * 1024 + col0; float s = 0.f; const float ra = __builtin_amdgcn_rsqf(pre[ai][m] * (1.0f / 512.0f) + eps);
#pragma unroll
                for (int bj = 0; bj < 2; ++bj) { const f32x4 x0 = __builtin_nontemporal_load((const f32x4*)(X + off + bj * HALF)), x1 = __builtin_nontemporal_load((const f32x4*)(X + off + bj * HALF + 4));
                    const f32x4 v0 = acc[ai][bj][m][0] * ra + x0, v1 = acc[ai][bj][m][1] * ra + x1;
                    s += (v0[0] * v0[0] + v0[1] * v0[1]) + (v0[2] * v0[2] + v0[3] * v0[3]) + (v1[0] * v1[0] + v1[1] * v1[1]) + (v1[2] * v1[2] + v1[3] * v1[3]);
                    u32x4 w; w.x = cvt_pk_bf16(v0[0], v0[1]); w.y = cvt_pk_bf16(v0[2], v0[3]); w.z = cvt_pk_bf16(v1[0], v1[1]); w.w = cvt_pk_bf16(v1[2], v1[3]);
                    *(u32x4*)(HB + off + bj * HALF) = w; }
                s += __shfl_xor(s, 16); s += __shfl_xor(s, 32);
                if (fq == 0) unsafeAtomicAdd(ssq + row, s * sscale); }
    }
};
struct EpiSwiGLU {
    static constexpr bool PERM = true, AFTER_DRAIN = false;
    const float* ssq; bf16_t* FF; float eps; mutable float pre[2][4], nxv[2][4];
    __device__ __forceinline__ void rotate() const {
#pragma unroll
        for (int ai = 0; ai < 2; ++ai)
#pragma unroll
            for (int m = 0; m < 4; ++m) pre[ai][m] = nxv[ai][m];
    }
    __device__ __forceinline__ void prefetch(const Unit& u, int wr, int fr) const {
        const int row0 = u.pm * BM + wr * 64 + fr;
#pragma unroll
        for (int ai = 0; ai < 2; ++ai)
#pragma unroll
            for (int m = 0; m < 4; ++m) nxv[ai][m] = ssq[row0 + ai * HALF + m * 16];
    }
    __device__ __forceinline__ void operator()(const f32x4 (&acc)[2][2][4][2], const Unit& u, int wr, int wc, int fr, int fq) const {
        const int row0 = u.pm * BM + wr * 64 + fr, col0 = u.pn * HALF + wc * 32 + 8 * fq;
#pragma unroll
        for (int ai = 0; ai < 2; ++ai)
#pragma unroll
            for (int m = 0; m < 4; ++m) { const int row = row0 + ai * HALF + m * 16; const float rstd = __builtin_amdgcn_rsqf(pre[ai][m] * (1.0f / 1024.0f) + eps);
                const float k1 = -1.4426950408889634f * rstd, r2 = rstd * rstd;
                unsigned wv[4];
#pragma unroll
                for (int n = 0; n < 2; ++n)
#pragma unroll
                    for (int h = 0; h < 2; ++h) { const f32x2 g2 = {acc[ai][0][m][n][2 * h], acc[ai][0][m][n][2 * h + 1]}, u2 = {acc[ai][1][m][n][2 * h], acc[ai][1][m][n][2 * h + 1]};
                        const f32x2 t = g2 * k1; f32x2 e; e.x = __builtin_amdgcn_exp2f(t.x); e.y = __builtin_amdgcn_exp2f(t.y);
                        const f32x2 d = e + 1.0f; f32x2 r; r.x = __builtin_amdgcn_rcpf(d.x); r.y = __builtin_amdgcn_rcpf(d.y);
                        const f32x2 o = (g2 * u2) * (r * r2); wv[n * 2 + h] = cvt_pk_bf16(o.x, o.y); }
                u32x4 w; w.x = wv[0]; w.y = wv[1]; w.z = wv[2]; w.w = wv[3];
                *(u32x4*)(FF + (size_t)row * 2816 + col0) = w; }
    }
};
struct EpiAccum {
    __device__ __forceinline__ void prefetch(const Unit&, int, int) const {}
    __device__ __forceinline__ void rotate() const {}
    static constexpr bool PERM = true, AFTER_DRAIN = false;
    float* OUT; const bf16_t* HB;
    __device__ __forceinline__ void operator()(const f32x4 (&acc)[2][2][4][2], const Unit& u, int wr, int wc, int fr, int fq) const {
        const int row0 = u.pm * BM + wr * 64 + fr, col0 = u.pn * BM + wc * 32 + 8 * fq;
#pragma unroll
        for (int ai = 0; ai < 2; ++ai)
#pragma unroll
            for (int m = 0; m < 4; ++m) { const size_t off = (size_t)(row0 + ai * HALF + m * 16) * 1024 + col0;
#pragma unroll
                for (int bj = 0; bj < 2; ++bj) { f32x4* p0 = (f32x4*)(OUT + off + bj * HALF); const u32x4 h = *(const u32x4*)(HB + off + bj * HALF);
                    const f32x4 x0 = {__builtin_bit_cast(float, h.x << 16), __builtin_bit_cast(float, h.x & 0xffff0000u), __builtin_bit_cast(float, h.y << 16), __builtin_bit_cast(float, h.y & 0xffff0000u)};
                    const f32x4 x1 = {__builtin_bit_cast(float, h.z << 16), __builtin_bit_cast(float, h.z & 0xffff0000u), __builtin_bit_cast(float, h.w << 16), __builtin_bit_cast(float, h.w & 0xffff0000u)};
                    __builtin_nontemporal_store(acc[ai][bj][m][0] + x0, p0); __builtin_nontemporal_store(acc[ai][bj][m][1] + x1, p0 + 1); } }
    }
};

template <class Epi, class Sched, bool ALIGN_EPI = false, bool SP2 = false>
__device__ __forceinline__ void gemm_phase(PG8_LAS unsigned char* lds, const Gemm g, const Sched& S, const Epi& E) {
    const int tid = threadIdx.x, wid = __builtin_amdgcn_readfirstlane(tid >> 6), lane = tid & 63, wr = wid >> 2, wc = wid & 3, fr = lane & 15, fq = lane >> 4;
    const int K = g.K, nt = K / BK;
    unsigned voffA[2], voffB[2];
#pragma unroll
    for (int i = 0; i < 2; ++i) { int R, C; stage_rc(tid * 16 + i * 8192, R, C); const int Rb = Epi::PERM ? ((R & ~31) + perm32(R & 31)) : R;
        voffA[i] = (unsigned)(R * K + C) * 2u; voffB[i] = (unsigned)(Rb * K + C) * 2u; }
    const size_t kstep = (size_t)(BK * 2);
    const size_t hstep = (size_t)HALF * K * 2;
    const size_t tstep = 2 * hstep;
    const unsigned ldsw = (unsigned)wid * 1024u;
    const int aoff = lds_byte(wr * 64 + fr, fq * 8), boff = lds_byte(wc * 32 + fr, fq * 8);
#define PG8_SA(b, h) (((b) * 2 + (h)) * HTB)
#define PG8_SB(b, h) ((4 + (b) * 2 + (h)) * HTB)
#define PG8_STAGE(bufoff, gbase, voff) do { _Pragma("unroll") for (int _i = 0; _i < 2; ++_i) \
        __builtin_amdgcn_global_load_lds((const unsigned*)((const char*)(gbase) + (voff)[_i]), (PG8_LAS unsigned*)(lds + (bufoff) + ldsw + _i * 8192), 16, 0, 0); } while (0)
#define PG8_LDA(dst, b, h) do { _Pragma("unroll") for (int m = 0; m < 4; ++m) _Pragma("unroll") for (int k = 0; k < 2; ++k) dst[m][k] = *(const PG8_LAS bf16x8*)(lds + PG8_SA(b, h) + aoff + m * 2048 + k * 1024); } while (0)
#define PG8_LDB(dst, b, h) do { _Pragma("unroll") for (int n = 0; n < 2; ++n) _Pragma("unroll") for (int k = 0; k < 2; ++k) dst[n][k] = *(const PG8_LAS bf16x8*)(lds + PG8_SB(b, h) + boff + n * 2048 + k * 1024); } while (0)
#define PG8_MMA(ai, bj, At, Bt) do { __builtin_amdgcn_s_setprio(1); _Pragma("unroll") for (int m = 0; m < 4; ++m) _Pragma("unroll") for (int n = 0; n < 2; ++n) _Pragma("unroll") for (int k = 0; k < 2; ++k) \
        acc[ai][bj][m][n] = __builtin_amdgcn_mfma_f32_16x16x32_bf16(Bt[n][k], At[m][k], acc[ai][bj][m][n], 0, 0, 0); __builtin_amdgcn_s_setprio(0); } while (0)
#define PG8_WAIT_V(n) asm volatile("s_waitcnt vmcnt(" #n ")" ::: "memory")
#define PG8_WAIT_L(n) asm volatile("s_waitcnt lgkmcnt(" #n ")" ::: "memory")
#define PG8_BAR __builtin_amdgcn_s_barrier()
#define PG8_SCHED __builtin_amdgcn_sched_barrier(0)
    Unit cur, nxt; int ui = 0;
    if (!S.next(0, cur)) return;
    f32x4 acc[2][2][4][2];
#pragma unroll
    for (int a = 0; a < 2; ++a)
#pragma unroll
        for (int b = 0; b < 2; ++b)
#pragma unroll
            for (int m = 0; m < 4; ++m)
#pragma unroll
                for (int n = 0; n < 2; ++n) acc[a][b][m][n] = (f32x4){0.f, 0.f, 0.f, 0.f};
    bf16x8 At[4][2], B0[2][2], B1[2][2];
    const char* cA = (const char*)g.A + (size_t)cur.pm * tstep; const char* cB = (const char*)g.Bt + (size_t)cur.pn * tstep;
    S.a_ready(cur); E.prefetch(cur, wr, fr); E.rotate();
    if constexpr (SP2) {
        PG8_STAGE(PG8_SB(0, 0), cB, voffB); PG8_STAGE(PG8_SB(0, 1), cB + hstep, voffB); PG8_STAGE(PG8_SA(0, 0), cA, voffA); PG8_STAGE(PG8_SA(0, 1), cA + hstep, voffA);
        if (wr == 1) PG8_BAR;
        PG8_WAIT_V(2); PG8_BAR;
        PG8_STAGE(PG8_SB(1, 0), cB + kstep, voffB); PG8_STAGE(PG8_SA(1, 0), cA + kstep, voffA); PG8_STAGE(PG8_SB(1, 1), cB + hstep + kstep, voffB);
        PG8_WAIT_V(6); PG8_BAR;
    } else {
        PG8_STAGE(PG8_SB(0, 0), cB, voffB); PG8_STAGE(PG8_SA(0, 0), cA, voffA); PG8_STAGE(PG8_SB(0, 1), cB + hstep, voffB); PG8_STAGE(PG8_SA(0, 1), cA + hstep, voffA);
        if (wr == 1) PG8_BAR;
        PG8_WAIT_V(4); PG8_BAR;
        PG8_STAGE(PG8_SB(1, 0), cB + kstep, voffB); PG8_STAGE(PG8_SA(1, 0), cA + kstep, voffA); PG8_STAGE(PG8_SB(1, 1), cB + hstep + kstep, voffB);
        PG8_WAIT_V(6); PG8_BAR;
    }
    for (;;) {
        const bool has_next = S.next(ui + 1, nxt);
        const char* nA = has_next ? (const char*)g.A + (size_t)nxt.pm * tstep : cA; const char* nB = has_next ? (const char*)g.Bt + (size_t)nxt.pn * tstep : cB;
        for (int t = 0; t < nt; t += 2) {
            const bool last = (t == nt - 2);
            const char* a1 = cA + (size_t)(t + 1) * kstep;
            const char* a2 = last ? nA : cA + (size_t)(t + 2) * kstep; const char* b2 = last ? nB : cB + (size_t)(t + 2) * kstep;
            const char* a3 = a2 + kstep; const char* b3 = b2 + kstep;
            if (last && has_next) { S.a_ready(nxt); E.prefetch(nxt, wr, fr); }
            if constexpr (SP2) {
            PG8_LDB(B0, 0, 0); PG8_LDB(B1, 0, 1); PG8_SCHED; PG8_LDA(At, 0, 0); PG8_STAGE(PG8_SA(1, 1), a1 + hstep, voffA);
            PG8_WAIT_V(8); PG8_WAIT_L(0); PG8_BAR; PG8_MMA(0, 0, At, B0); PG8_MMA(0, 1, At, B1); PG8_BAR; PG8_SCHED;
            PG8_LDA(At, 0, 1); PG8_STAGE(PG8_SB(0, 0), b2, voffB); PG8_STAGE(PG8_SB(0, 1), b2 + hstep, voffB); PG8_STAGE(PG8_SA(0, 0), a2, voffA);
            PG8_WAIT_V(8); PG8_WAIT_L(0); PG8_BAR; PG8_MMA(1, 0, At, B0); PG8_MMA(1, 1, At, B1); PG8_BAR; PG8_SCHED;
            PG8_LDB(B0, 1, 0); PG8_LDB(B1, 1, 1); PG8_SCHED; PG8_LDA(At, 1, 0); PG8_STAGE(PG8_SA(0, 1), a2 + hstep, voffA);
            PG8_WAIT_V(8); PG8_WAIT_L(0); PG8_BAR; PG8_MMA(0, 0, At, B0); PG8_MMA(0, 1, At, B1); PG8_BAR; PG8_SCHED;
            PG8_LDA(At, 1, 1); PG8_STAGE(PG8_SB(1, 0), b3, voffB); PG8_STAGE(PG8_SB(1, 1), b3 + hstep, voffB); PG8_STAGE(PG8_SA(1, 0), a3, voffA);
            PG8_WAIT_V(8); PG8_WAIT_L(0); PG8_BAR; PG8_MMA(1, 0, At, B0); PG8_MMA(1, 1, At, B1); PG8_BAR; PG8_SCHED;
            } else {
            PG8_LDB(B0, 0, 0); PG8_SCHED; PG8_LDA(At, 0, 0); PG8_STAGE(PG8_SA(1, 1), a1 + hstep, voffA);
            PG8_WAIT_L(8); PG8_BAR; PG8_WAIT_L(0); PG8_MMA(0, 0, At, B0); PG8_BAR; PG8_SCHED;
            PG8_LDB(B1, 0, 1); PG8_STAGE(PG8_SB(0, 0), b2, voffB);
            PG8_BAR; PG8_WAIT_L(0); PG8_MMA(0, 1, At, B1); PG8_BAR;
            PG8_LDA(At, 0, 1); PG8_STAGE(PG8_SA(0, 0), a2, voffA);
            PG8_BAR; PG8_WAIT_L(0); PG8_MMA(1, 0, At, B0); PG8_BAR; PG8_SCHED;
            PG8_STAGE(PG8_SB(0, 1), b2 + hstep, voffB);
            PG8_WAIT_V(6); PG8_BAR; PG8_MMA(1, 1, At, B1); PG8_BAR;
            PG8_LDB(B0, 1, 0); PG8_SCHED; PG8_LDA(At, 1, 0); PG8_STAGE(PG8_SA(0, 1), a2 + hstep, voffA);
            PG8_WAIT_L(8); PG8_BAR; PG8_WAIT_L(0); PG8_MMA(0, 0, At, B0); PG8_BAR; PG8_SCHED;
            PG8_LDB(B1, 1, 1); PG8_STAGE(PG8_SB(1, 0), b3, voffB);
            PG8_BAR; PG8_WAIT_L(0); PG8_MMA(0, 1, At, B1); PG8_BAR;
            PG8_LDA(At, 1, 1); PG8_STAGE(PG8_SA(1, 0), a3, voffA);
            PG8_BAR; PG8_WAIT_L(0); PG8_MMA(1, 0, At, B0); PG8_BAR; PG8_SCHED;
            PG8_STAGE(PG8_SB(1, 1), b3 + hstep, voffB);
            PG8_WAIT_V(6); PG8_BAR; PG8_MMA(1, 1, At, B1); PG8_BAR;
            }
        }
        if constexpr (ALIGN_EPI) { if (wr == 0) PG8_BAR; }
        if constexpr (!Epi::AFTER_DRAIN) { E(acc, cur, wr, wc, fr, fq); E.rotate(); S.done(cur); }
        if (!has_next) break;
#pragma unroll
        for (int a = 0; a < 2; ++a)
#pragma unroll
            for (int b = 0; b < 2; ++b)
#pragma unroll
                for (int m = 0; m < 4; ++m)
#pragma unroll
                    for (int n = 0; n < 2; ++n) acc[a][b][m][n] = (f32x4){0.f, 0.f, 0.f, 0.f};
        cur = nxt; cA = nA; cB = nB; ++ui;
        if constexpr (ALIGN_EPI) { if (wr == 1) PG8_BAR; }
    }
    PG8_WAIT_V(0);
    if constexpr (!ALIGN_EPI) { if (wr == 0) PG8_BAR; }
    PG8_BAR;
    if constexpr (Epi::AFTER_DRAIN) { E.fused(acc, cur, wr, wc, fr, fq, lds, wid, lane); S.done(cur); }
#undef PG8_SA
#undef PG8_SB
#undef PG8_STAGE
#undef PG8_LDA
#undef PG8_LDB
#undef PG8_MMA
#undef PG8_WAIT_V
#undef PG8_WAIT_L
#undef PG8_BAR
#undef PG8_SCHED
}
}
#ifndef PG8_SP2
#define PG8_SP2 true
#endif
#ifndef PG8_ALIGN
#define PG8_ALIGN true
#endif
#include <hip/hip_bf16.h>
#include <cmath>
namespace attn_body {
using bf16=__hip_bfloat16;
using bf16x8=__attribute__((ext_vector_type(8)))short;
using s16x4=__attribute__((ext_vector_type(4)))short;
using f32x16=__attribute__((ext_vector_type(16)))float;
using u32x4=__attribute__((ext_vector_type(4)))unsigned;
constexpr int BATCH=16,NHEAD=8,SEQ=2048,D=64,QP=1792,KP=1792,OP=1024;
constexpr int NW=8,QBLK=32,QB=QBLK*NW,KVBLK=64,NQB=SEQ/QB;
constexpr int ATTN_UNIT_ROWS=QB;
__device__ __forceinline__ int crow(int r,int hi){return (r&3)+8*(r>>2)+4*hi;}
#define SBAR() __builtin_amdgcn_sched_barrier(0)
__device__ __forceinline__ void cmask(f32x16&p0,f32x16&p1,int jb,int qrel,int hi){
  const float NEG=-INFINITY; int kb=64*jb+4*hi;
  #pragma unroll
  for(int r=0;r<16;++r){int kv=kb+(r&3)+8*(r>>2); if(kv>qrel)p0[r]=NEG; if(kv+32>qrel)p1[r]=NEG;}
}

constexpr int NSLOT=3, SLOTB=8192;
constexpr int LDS_K=0, LDS_V=NSLOT*SLOTB, LDS_WS=2*NSLOT*SLOTB, LDS_OST=LDS_WS+NW*64*4, LDS_BYTES=LDS_OST+NW*4096;
constexpr float C2=0.125f*1.4426950408889634f;
__device__ __forceinline__ void glds16(const void*gsrc,unsigned lds_dst){unsigned keep;
  asm volatile("s_mov_b32 %0, m0\n\ts_mov_b32 m0, %2\n\ts_nop 0\n\tglobal_load_lds_dwordx4 %1, off\n\ts_mov_b32 m0, %0":"=&s"(keep):"v"(gsrc),"s"(lds_dst):"memory");}
__device__ __forceinline__ float max3f(float a,float b,float c){float r;asm("v_max3_f32 %0, %1, %2, %3":"=v"(r):"v"(a),"v"(b),"v"(c));return r;}
__device__ __forceinline__ float max2f(float a,float b){float r;asm("v_max_f32_e32 %0, %1, %2":"=v"(r):"v"(a),"v"(b));return r;}
__device__ __forceinline__ float fadd_s(float a,float b){float r;asm("v_add_f32_e32 %0, %1, %2":"=v"(r):"v"(a),"v"(b));return r;}
__device__ __forceinline__ float fsub_s(float a,float b){float r;asm("v_sub_f32_e32 %0, %1, %2":"=v"(r):"v"(a),"v"(b));return r;}
typedef float f32x2_t __attribute__((ext_vector_type(2))); typedef __bf16 bf16x2_t __attribute__((ext_vector_type(2)));
__device__ __forceinline__ unsigned cvtpk_s(float lo,float hi){f32x2_t v={lo,hi};bf16x2_t b=__builtin_convertvector(v,bf16x2_t);return __builtin_bit_cast(unsigned,b);}
#define WAIT_BAR(N) asm volatile("s_waitcnt vmcnt(" #N ") lgkmcnt(0)\n\ts_barrier":::"memory")

__device__ __forceinline__ void qkt(f32x16&p0,f32x16&p1,const char*Kslot,const bf16x8*qr,const f32x16&negm,int r32,int hi){
  const char*kb=Kslot+hi*1024+r32*16;
  #pragma unroll
  for(int d0=0;d0<4;++d0){
    const bf16x8 b0=*reinterpret_cast<const bf16x8*>(kb+d0*2048);
    const bf16x8 b1=*reinterpret_cast<const bf16x8*>(kb+d0*2048+512);
    if(d0==0){p0=__builtin_amdgcn_mfma_f32_32x32x16_bf16(b0,qr[0],negm,0,0,0);p1=__builtin_amdgcn_mfma_f32_32x32x16_bf16(b1,qr[0],negm,0,0,0);}
    else{p0=__builtin_amdgcn_mfma_f32_32x32x16_bf16(b0,qr[d0],p0,0,0,0);p1=__builtin_amdgcn_mfma_f32_32x32x16_bf16(b1,qr[d0],p1,0,0,0);}}
}
typedef __attribute__((address_space(3))) const char* lds_cptr;
typedef short v4i16_t __attribute__((ext_vector_type(4)));
__device__ __forceinline__ void kload8(bf16x8*kf,lds_cptr kp){
  kf[0]=*(const __attribute__((address_space(3))) bf16x8*)(kp);      kf[1]=*(const __attribute__((address_space(3))) bf16x8*)(kp+512);
  kf[2]=*(const __attribute__((address_space(3))) bf16x8*)(kp+2048); kf[3]=*(const __attribute__((address_space(3))) bf16x8*)(kp+2560);
  kf[4]=*(const __attribute__((address_space(3))) bf16x8*)(kp+4096); kf[5]=*(const __attribute__((address_space(3))) bf16x8*)(kp+4608);
  kf[6]=*(const __attribute__((address_space(3))) bf16x8*)(kp+6144); kf[7]=*(const __attribute__((address_space(3))) bf16x8*)(kp+6656);
}
__device__ __forceinline__ void kload2(bf16x8*kf,lds_cptr kp,int j){ kf[2*j]=*(const __attribute__((address_space(3))) bf16x8*)(kp+j*2048); kf[2*j+1]=*(const __attribute__((address_space(3))) bf16x8*)(kp+j*2048+512); }
__device__ __forceinline__ s16x4 vtr(lds_cptr p){ return __builtin_bit_cast(s16x4,__builtin_amdgcn_ds_read_tr16_b64_v4i16((__attribute__((address_space(3))) v4i16_t*)p)); }
__device__ __forceinline__ float rowmax(const f32x16&p0,const f32x16&p1){
  float a=max3f(p0[0],p0[1],p1[0]),b=max3f(p0[2],p0[3],p1[1]);a=max3f(a,p1[2],p1[3]);
  #pragma unroll
  for(int r=4;r<16;r+=4){a=max3f(a,p0[r],p0[r+1]);b=max3f(b,p0[r+2],p0[r+3]);a=max3f(a,p1[r],p1[r+1]);b=max3f(b,p1[r+2],p1[r+3]);}
  const float m=max2f(a,b);
  auto rr=__builtin_amdgcn_permlane32_swap(__float_as_uint(m),__float_as_uint(m),false,false);
  return max2f(__uint_as_float(rr[0]),__uint_as_float(rr[1]));
}
__device__ __forceinline__ void pv(f32x16*o,int vb,bf16x8 pa0,bf16x8 pa1,bf16x8 pa2,bf16x8 pa3){
  #pragma unroll
  for(int d0=0;d0<2;++d0){s16x4 lo[4],hi[4];
    #pragma unroll
    for(int ks=0;ks<4;++ks){
      asm volatile("ds_read_b64_tr_b16 %0,%1 offset:%c2":"=&v"(lo[ks]):"v"(vb),"i"(d0*4096+ks*1024):"memory");
      asm volatile("ds_read_b64_tr_b16 %0,%1 offset:%c2":"=&v"(hi[ks]):"v"(vb),"i"(d0*4096+ks*1024+512):"memory");}
    asm volatile("s_waitcnt lgkmcnt(0)":::"memory");SBAR();
    #define PK(k) (bf16x8){lo[k][0],lo[k][1],lo[k][2],lo[k][3],hi[k][0],hi[k][1],hi[k][2],hi[k][3]}
    o[d0]=__builtin_amdgcn_mfma_f32_32x32x16_bf16(pa0,PK(0),o[d0],0,0,0);
    o[d0]=__builtin_amdgcn_mfma_f32_32x32x16_bf16(pa1,PK(1),o[d0],0,0,0);
    o[d0]=__builtin_amdgcn_mfma_f32_32x32x16_bf16(pa2,PK(2),o[d0],0,0,0);
    o[d0]=__builtin_amdgcn_mfma_f32_32x32x16_bf16(pa3,PK(3),o[d0],0,0,0);
    #undef PK
  }
}

#ifndef ATTN_STORE16
#define ATTN_STORE16(p,v) (*(u32x4*)(p)=(v))
#endif
template<int THRL,bool NOMAX> __device__ __forceinline__ void attn_unit(int b,int h,int qb,const bf16*Q,const bf16*__restrict__ K,const bf16*__restrict__ V,bf16*O,char*shm,const float*qn,const __attribute__((address_space(3))) float*tab,float*ssqa){
  const int tid=threadIdx.x,lane=tid&63,r32=lane&31,hi=lane>>5; const int wid=__builtin_amdgcn_readfirstlane(tid>>6);
  const long rowbase=(long)b*SEQ; const int q0=qb*QB;
  const bf16*Qw=Q+(rowbase+q0+wid*QBLK)*QP+h*D;
  const int kvh=h>>2; const bf16*Kh=K+rowbase*KP+kvh*D,*Vh=V+rowbase*KP+kvh*D;
  const unsigned lds0=(unsigned)(uintptr_t)shm;
  float*wsf=(float*)(shm+LDS_WS)+wid*64;
  const bf16*ksrc=Kh+(long)lane*KP+wid*8;
  const bf16*vsrc=Vh+(long)(16*(wid&3)+(lane>>2))*KP+(wid>>2)*32+(lane&3)*8;
  const unsigned kdst=lds0+LDS_K+wid*1024, vdst=lds0+LDS_V+wid*1024;
  #define DMA_K(t,slot) glds16(ksrc+(long)(t)*KVBLK*KP,(unsigned)__builtin_amdgcn_readfirstlane(kdst+(slot)))
  #define DMA_V(t,slot) glds16(vsrc+(long)(t)*KVBLK*KP,(unsigned)__builtin_amdgcn_readfirstlane(vdst+(slot)))
  const int vb0=(int)(lds0+LDS_V)+((lane>>4)&1)*32+(lane&3)*8+(4*hi+((lane&15)>>2))*64;
  const char*Kbase=shm+LDS_K; bf16x8 kf[8];
  const lds_cptr shm3=(lds_cptr)shm; const lds_cptr kp0=shm3+LDS_K+hi*1024+r32*16; const lds_cptr vp0=shm3+LDS_V+((lane>>4)&1)*32+(lane&3)*8+(4*hi+((lane&15)>>2))*64;
  const int NT=SEQ/KVBLK;
  DMA_K(0,0);DMA_V(0,0);DMA_K(1,SLOTB);
  bf16x8 qr[4];
  #pragma unroll
  for(int d0=0;d0<4;++d0)qr[d0]=*reinterpret_cast<const bf16x8*>(&Qw[(long)r32*QP+d0*16+hi*8]);
  { typedef float f32x4_t __attribute__((ext_vector_type(4))); typedef __attribute__((address_space(3))) const f32x4_t* ltab4;
    float f[4][8]; float ss=0.f;
    #pragma unroll
    for(int d0=0;d0<4;++d0){
      #pragma unroll
      for(int j=0;j<8;++j){ f[d0][j]=__uint_as_float(((unsigned)(unsigned short)qr[d0][j])<<16); ss+=f[d0][j]*f[d0][j]; } }
    ss+=__shfl_xor(ss,32);
    const float rstd=1.0f/sqrtf(ss*(1.0f/64.0f)+1e-6f);
    const int tq_=q0+wid*QBLK+r32, prow=tq_>>6, pcol=tq_&63;
    float cr[8],sr[8],cc[8],sc[8];
    #pragma unroll
    for(int hf=0;hf<2;++hf){ const f32x4_t a=*(ltab4)(tab+prow*16+8*hi+4*hf), b2=*(ltab4)(tab+1024+prow*16+8*hi+4*hf), c=*(ltab4)(tab+pcol*16+8*hi+4*hf), d=*(ltab4)(tab+1024+pcol*16+8*hi+4*hf);
      #pragma unroll
      for(int e=0;e<4;++e){ cr[4*hf+e]=a[e]; sr[4*hf+e]=b2[e]; cc[4*hf+e]=c[e]; sc[4*hf+e]=d[e]; } }
    float g0[8],g1[8],g2[8],g3[8];
    #pragma unroll
    for(int hf=0;hf<2;++hf){ const f32x4_t a=*(ltab4)(tab+2048+8*hi+4*hf), b2=*(ltab4)(tab+2048+16+8*hi+4*hf), c=*(ltab4)(tab+2048+32+8*hi+4*hf), d=*(ltab4)(tab+2048+48+8*hi+4*hf);
      #pragma unroll
      for(int e=0;e<4;++e){ g0[4*hf+e]=a[e]; g1[4*hf+e]=b2[e]; g2[4*hf+e]=c[e]; g3[4*hf+e]=d[e]; } }
    u32x4 pk[4];
    #pragma unroll
    for(int jj=0;jj<4;++jj){ float o0[2],o1[2],o2[2],o3[2];
      #pragma unroll
      for(int e=0;e<2;++e){ const int j=2*jj+e; const float sc2=rstd*C2;
        const float n0=f[0][j]*sc2*g0[j], n1=f[1][j]*sc2*g1[j], n2=f[2][j]*sc2*g2[j], n3=f[3][j]*sc2*g3[j];
        o0[e]=n0*cr[j]-n1*sr[j]; o1[e]=n1*cr[j]+n0*sr[j]; o2[e]=n2*cc[j]-n3*sc[j]; o3[e]=n3*cc[j]+n2*sc[j]; }
      pk[0][jj]=cvtpk_s(o0[0],o0[1]); pk[1][jj]=cvtpk_s(o1[0],o1[1]); pk[2][jj]=cvtpk_s(o2[0],o2[1]); pk[3][jj]=cvtpk_s(o3[0],o3[1]); }
    #pragma unroll
    for(int d0=0;d0<4;++d0)qr[d0]=__builtin_bit_cast(bf16x8,pk[d0]);
  }
  float mhat=0.f,l_reg=0.f;f32x16 o[2];o[0]=f32x16{};o[1]=f32x16{};f32x16 negm=f32x16{};asm volatile("":"+v"(negm));
  const int qrel=wid*QBLK+r32;
  #define CMASK(P0,P1,t) do{}while(0)
  bool resc=false;
  #define START(P0,P1) do{ resc=false; \
    if constexpr(!NOMAX){ const float rm=rowmax(P0,P1); const float dl=rm; mhat=fadd_s(mhat,dl); \
      _Pragma("unroll") for(int r=0;r<16;++r){P0[r]=fsub_s(P0[r],dl);P1[r]=fsub_s(P1[r],dl);} \
      _Pragma("unroll") for(int r=0;r<16;++r)negm[r]=-mhat; asm volatile("":"+v"(negm)); } \
    _Pragma("unroll") for(int r=0;r<16;++r)P0[r]=__builtin_amdgcn_exp2f(P0[r]); }while(0)
  #define RESC() do{ if(resc){ asm volatile("s_waitcnt lgkmcnt(0)":::"memory"); \
      _Pragma("unroll") for(int d_=0;d_<2;++d_) _Pragma("unroll") for(int r=0;r<16;++r)o[d_][r]*=wsf[crow(r,hi)]; } }while(0)
  f32x16 pA0,pA1,pB0,pB1;
  int sl_prev=0,sl_cur=0,sl_next=SLOTB;
  #define ROT() do{sl_prev=sl_cur;sl_cur=sl_next;sl_next=(sl_next==(NSLOT-1)*SLOTB)?0:sl_next+SLOTB;}while(0)
  DMA_K(2,2*SLOTB);
  WAIT_BAR(3);
  qkt(pA0,pA1,Kbase,qr,negm,r32,hi);asm volatile("s_nop 15\n\ts_nop 7":"+v"(pA0),"+v"(pA1));CMASK(pA0,pA1,0);
  START(pA0,pA1);
  _Pragma("unroll") for(int r=0;r<16;++r)pA1[r]=__builtin_amdgcn_exp2f(pA1[r]);
  WAIT_BAR(0);
  DMA_K(3,0);DMA_V(1,SLOTB);
  ROT();
  kload8(kf,kp0+sl_cur);
  WAIT_BAR(2);
  s16x4 vlo[8],vhi[8]; u32x4 pw0,pw1,pw2,pw3;
  #define PKW(P,B) cvtpk_s(P[B],P[B+1])
  #define PAF(k) __builtin_bit_cast(bf16x8,pw##k)
  #define VFR(i) (bf16x8){vlo[i][0],vlo[i][1],vlo[i][2],vlo[i][3],vhi[i][0],vhi[i][1],vhi[i][2],vhi[i][3]}
  #define PIN(x) asm volatile("":"+v"(x))
  #define MX3(a,b,c) __builtin_fmaxf(__builtin_fmaxf((a),(b)),(c))
  #define GAPA(MF,A0,A1,A2,A3,W0,W1,PW) do{ MF; sacc+=A0; sacc+=A1; sacc+=A2; sacc+=A3; PIN(sacc); W0; W1; PIN(PW); SBAR(); }while(0)
  #define EX(v) __builtin_amdgcn_exp2f(v)
  #define GAPB(MF,X,B) do{ MF; X[B]=EX(X[B]); X[B+1]=EX(X[B+1]); X[B+2]=EX(X[B+2]); X[B+3]=EX(X[B+3]); PIN(X); SBAR(); }while(0)
  #define VRD(i) do{ vlo[i]=vtr(vp_+(((i)>>2)*4096+((i)&3)*1024)); vhi[i]=vtr(vp_+(((i)>>2)*4096+((i)&3)*1024+512)); }while(0)
  #define KRD(G,j) do{ if(G){ kload2(kf,kp0+sl_next,j); SBAR(); } }while(0)
  #define STEP(C0,C1,P0,P1,t,GK,GV,GL) do{ SBAR(); \
    const lds_cptr vp_=vp0+sl_prev; \
    VRD(0); SBAR(); float sacc=(P0[0]+P0[1]); \
    GAPA(C0=__builtin_amdgcn_mfma_f32_32x32x16_bf16(kf[0],qr[0],negm,0,0,0), P0[2],P0[3],P0[4],P0[5],     pw0[0]=PKW(P0,0), pw0[1]=PKW(P0,2), pw0); \
    VRD(4); SBAR(); GAPA(C1=__builtin_amdgcn_mfma_f32_32x32x16_bf16(kf[1],qr[0],negm,0,0,0), P0[6],P0[7],P0[8],P0[9],     pw0[2]=PKW(P0,4), pw0[3]=PKW(P0,6), pw0); \
    VRD(1); SBAR(); GAPA(C0=__builtin_amdgcn_mfma_f32_32x32x16_bf16(kf[2],qr[1],C0,0,0,0),   P0[10],P0[11],P0[12],P0[13], pw1[0]=PKW(P0,8), pw1[1]=PKW(P0,10), pw1); \
    VRD(5); SBAR(); GAPA(C1=__builtin_amdgcn_mfma_f32_32x32x16_bf16(kf[3],qr[1],C1,0,0,0),   P0[14],P0[15],P1[0],P1[1],   pw1[2]=PKW(P0,12),pw1[3]=PKW(P0,14), pw1); \
    VRD(2); SBAR(); GAPA(C0=__builtin_amdgcn_mfma_f32_32x32x16_bf16(kf[4],qr[2],C0,0,0,0),   P1[2],P1[3],P1[4],P1[5],     pw2[0]=PKW(P1,0), pw2[1]=PKW(P1,2), pw2); \
    VRD(6); SBAR(); GAPA(C1=__builtin_amdgcn_mfma_f32_32x32x16_bf16(kf[5],qr[2],C1,0,0,0),   P1[6],P1[7],P1[8],P1[9],     pw2[2]=PKW(P1,4), pw2[3]=PKW(P1,6), pw2); \
    VRD(3); SBAR(); GAPA(C0=__builtin_amdgcn_mfma_f32_32x32x16_bf16(kf[6],qr[3],C0,0,0,0),   P1[10],P1[11],P1[12],P1[13], pw3[0]=PKW(P1,8), pw3[1]=PKW(P1,10), pw3); \
    VRD(7); SBAR(); GAPA(C1=__builtin_amdgcn_mfma_f32_32x32x16_bf16(kf[7],qr[3],C1,0,0,0),   P1[14],P1[15],0.f,0.f,       pw3[2]=PKW(P1,12),pw3[3]=PKW(P1,14), pw3); \
    l_reg+=sacc; \
    if(GK){DMA_K((t)+3,sl_cur);} if(GV){DMA_V((t)+1,sl_next);} \
    CMASK(C0,C1,t); \
    if constexpr(NOMAX){ resc=false; } else { float a=MX3(C0[0],C0[1],C1[0]),b=MX3(C0[2],C0[3],C1[1]); a=MX3(a,C1[2],C1[3]); \
      _Pragma("unroll") for(int r=4;r<16;r+=4){a=MX3(a,C0[r],C0[r+1]);b=MX3(b,C0[r+2],C0[r+3]);a=MX3(a,C1[r],C1[r+1]);b=MX3(b,C1[r+2],C1[r+3]);} \
      float rm=__builtin_fmaxf(a,b); { auto rr=__builtin_amdgcn_permlane32_swap(__float_as_uint(rm),__float_as_uint(rm),false,false); rm=__builtin_fmaxf(__uint_as_float(rr[0]),__uint_as_float(rr[1])); } \
      resc=false; \
      if(__builtin_expect(__any(rm>(float)THRL),0)){ const float dl=__builtin_fmaxf(rm,0.f); mhat+=dl; \
        _Pragma("unroll") for(int r=0;r<16;++r){C0[r]-=dl;C1[r]-=dl;} \
        _Pragma("unroll") for(int r=0;r<16;++r)negm[r]=-mhat; asm volatile("":"+v"(negm)); \
        const float f=__builtin_amdgcn_exp2f(-dl); l_reg*=f; if(hi==0)wsf[r32]=f; resc=true; } } \
    SBAR(); \
    GAPB(o[0]=__builtin_amdgcn_mfma_f32_32x32x16_bf16(PAF(0),VFR(0),o[0],0,0,0), C0,0); \
    GAPB(o[1]=__builtin_amdgcn_mfma_f32_32x32x16_bf16(PAF(0),VFR(4),o[1],0,0,0), C0,4); \
    KRD(GL,0); GAPB(o[0]=__builtin_amdgcn_mfma_f32_32x32x16_bf16(PAF(1),VFR(1),o[0],0,0,0), C0,8); \
    KRD(GL,1); GAPB(o[1]=__builtin_amdgcn_mfma_f32_32x32x16_bf16(PAF(1),VFR(5),o[1],0,0,0), C0,12); \
    KRD(GL,2); GAPB(o[0]=__builtin_amdgcn_mfma_f32_32x32x16_bf16(PAF(2),VFR(2),o[0],0,0,0), C1,0); \
    KRD(GL,3); GAPB(o[1]=__builtin_amdgcn_mfma_f32_32x32x16_bf16(PAF(2),VFR(6),o[1],0,0,0), C1,4); \
    GAPB(o[0]=__builtin_amdgcn_mfma_f32_32x32x16_bf16(PAF(3),VFR(3),o[0],0,0,0), C1,8); \
    GAPB(o[1]=__builtin_amdgcn_mfma_f32_32x32x16_bf16(PAF(3),VFR(7),o[1],0,0,0), C1,12); \
    }while(0)
  int t=1;
  #undef CMASK
  #define CMASK(P0,P1,t) do{}while(0)
  for(;t+5<NT;t+=2){
    STEP(pB0,pB1,pA0,pA1,t,true,true,true);     WAIT_BAR(2); RESC(); ROT();
    STEP(pA0,pA1,pB0,pB1,t+1,true,true,true);   WAIT_BAR(2); RESC(); ROT();
  }
  #undef CMASK
  #define CMASK(P0,P1,t) do{}while(0)
  #define ENDW(tt) do{ if((tt)+3<NT){WAIT_BAR(2);} else if((tt)+2<NT){WAIT_BAR(1);} else {WAIT_BAR(0);} }while(0)
  for(;t+1<NT;t+=2){
    STEP(pB0,pB1,pA0,pA1,t,(t+3<NT),(t+1<NT),(t+1<NT));       ENDW(t);   RESC(); ROT();
    STEP(pA0,pA1,pB0,pB1,t+1,(t+4<NT),(t+2<NT),(t+2<NT));     ENDW(t+1); RESC(); ROT();
  }
  STEP(pB0,pB1,pA0,pA1,NT-1,false,false,false); RESC();
  { float sacc=pB0[0]+pB0[1]; _Pragma("unroll") for(int r=2;r<16;++r)sacc+=pB0[r]; _Pragma("unroll") for(int r=0;r<16;++r)sacc+=pB1[r]; l_reg+=sacc;
    pw0=(u32x4){PKW(pB0,0),PKW(pB0,2),PKW(pB0,4),PKW(pB0,6)};pw1=(u32x4){PKW(pB0,8),PKW(pB0,10),PKW(pB0,12),PKW(pB0,14)};pw2=(u32x4){PKW(pB1,0),PKW(pB1,2),PKW(pB1,4),PKW(pB1,6)};pw3=(u32x4){PKW(pB1,8),PKW(pB1,10),PKW(pB1,12),PKW(pB1,14)};
    SBAR(); pv(o,vb0+sl_cur,PAF(0),PAF(1),PAF(2),PAF(3)); }
  #undef PKW
  #undef PAF
  #undef VFR
  #undef PIN
  #undef MX3
  #undef GAPA
  #undef GAPB
  #undef EX
  #undef VRD
  #undef KRD
  #undef STEP
  #undef ENDW
  {auto rr=__builtin_amdgcn_permlane32_swap(__float_as_uint(l_reg),__float_as_uint(l_reg),false,false);l_reg=__uint_as_float(rr[0])+__uint_as_float(rr[1]);}
  if(hi==0)wsf[32+r32]=l_reg;asm volatile("s_waitcnt lgkmcnt(0)":::"memory");
  float rli[16];
  #pragma unroll
  for(int r=0;r<16;++r)rli[r]=__builtin_amdgcn_rcpf(wsf[32+crow(r,hi)]);
  bf16*Ow=O+(rowbase+q0+wid*QBLK)*OP+h*D;
  { bf16*stg=(bf16*)(shm+LDS_OST)+wid*2048;
    #pragma unroll
    for(int r=0;r<16;++r){const int orow=crow(r,hi);
      #pragma unroll
      for(int d0=0;d0<2;++d0)stg[orow*64+d0*32+r32]=__float2bfloat16(o[d0][r]*rli[r]);}
    asm volatile("s_waitcnt lgkmcnt(0)":::"memory");
    #pragma unroll
    for(int i=0;i<4;++i){const int row=i*8+(lane>>3),ch=lane&7; const u32x4 v=*(const u32x4*)(stg+row*64+ch*8); ATTN_STORE16(Ow+(long)row*OP+ch*8,v);
      float sq=0.f;
      #pragma unroll
      for(int k=0;k<4;++k){const float lo=__uint_as_float(v[k]<<16),hh=__uint_as_float(v[k]&0xffff0000u); sq+=lo*lo+hh*hh;}
      sq+=__shfl_xor(sq,1);sq+=__shfl_xor(sq,2);sq+=__shfl_xor(sq,4);
      if(ch==0)unsafeAtomicAdd(ssqa+rowbase+q0+wid*QBLK+row,sq);} }
  asm volatile("s_waitcnt lgkmcnt(0)\n\ts_barrier":::"memory");
  #undef DMA_K
  #undef DMA_V
  #undef CMASK
  #undef START
  #undef RESC
  #undef ROT
}
constexpr int ATTN_LDS_BYTES=LDS_BYTES;
struct AttnTensors { const bf16* Q; const bf16* K; const bf16* V; bf16* O; const float* qn; const __attribute__((address_space(3))) float* tab; float* ssqa; };
template<int THRL=8> __device__ __forceinline__ void attn_phase(char*lds,const AttnTensors&T,int grid,int block,bool nomax){
  const int vcu=(grid%8==0)?(block%8)*(grid/8)+block/8:block;
  constexpr int NU=BATCH*NHEAD*NQB;
  const int per=(NU+grid-1)/grid;
  for(int i=0;i<per;++i){ const int u=vcu*per+i; if(u>=NU)break; const int g=u>>5, hl=(u>>3)&3, qb=u&7; const int b=g>>1, kv=g&1;
    if(nomax)attn_unit<THRL,true>(b,kv*4+hl,qb,T.Q,T.K,T.V,T.O,lds,T.qn,T.tab,T.ssqa); else attn_unit<THRL,false>(b,kv*4+hl,qb,T.Q,T.K,T.V,T.O,lds,T.qn,T.tab,T.ssqa); }
}
#undef SBAR
#undef WAIT_BAR
}
#ifndef PROBE_DUP
#define PROBE_DUP -1
#endif
#ifndef PROBE_MASK
#define PROBE_MASK ((PROBE_DUP >= 0) ? (1 << PROBE_DUP) : 0)
#endif
#define REP(k) for (int rep_ = 0; rep_ < (((PROBE_MASK >> (k)) & 1) ? 2 : 1); ++rep_)
#ifndef MK_LAUNCHES
#define MK_LAUNCHES 1
#endif
constexpr int NWAVES = 8;
constexpr int BATCH = 16, SEQ = 2048, DMODEL = 1024, M = BATCH * SEQ;
constexpr int D_IN = 1792, D_FF = 2816, NGU = 2 * D_FF;
constexpr int COL_K = 512, COL_V = 640, COL_XL = 768, COL_GL = 1280;
constexpr float EPS = 1e-6f;
constexpr float L2E = 1.4426950408889634f;
constexpr int NPHASE = 8;
constexpr size_t MiB = 1u << 20;
constexpr size_t WS_CTL = 0, CTL_ZERO_BYTES = 16384;
constexpr size_t WS_SSQ = 65536;
constexpr size_t WS_SSQA = 65536 + 131072;
constexpr size_t WS_WIN = 1 * MiB, WS_WOUT = 5 * MiB, WS_WGU = 7 * MiB, WS_WD = 18 * MiB;
constexpr size_t WS_XN = 32 * MiB;
constexpr size_t WS_PROJ = 96 * MiB;
constexpr size_t WS_ATT = 208 * MiB;
constexpr size_t WS_YF = 240 * MiB, WS_YB = 272 * MiB;
constexpr size_t WS_FF = 32 * MiB;
constexpr size_t WS_H1B = 208 * MiB;
constexpr size_t WS_END = 304 * MiB;
constexpr int MISC_OFF = 131072, ROPE_TAB_OFF = 131072 + 1024;
constexpr int LDS_BYTES = 147456;
#define LAS __attribute__((address_space(3)))
typedef unsigned short bf16;
typedef unsigned v4u __attribute__((ext_vector_type(4)));
typedef unsigned v2u __attribute__((ext_vector_type(2)));
typedef float f32x4 __attribute__((ext_vector_type(4)));
typedef float f32x16 __attribute__((ext_vector_type(16)));
typedef float f32x2v __attribute__((ext_vector_type(2)));
typedef short bf16x8 __attribute__((ext_vector_type(8)));
#define LDS_WAIT() asm volatile("s_waitcnt lgkmcnt(0)" ::: "memory")
__device__ __forceinline__ unsigned f2bf(float f) { unsigned u = __builtin_bit_cast(unsigned, f); return (u + 0x7fffu + ((u >> 16) & 1u)) >> 16; }
__device__ __forceinline__ unsigned pk2(float lo, float hi) { return pg8::cvt_pk_bf16(lo, hi); }
__device__ __forceinline__ float bflo(unsigned u) { return __builtin_bit_cast(float, u << 16); }
__device__ __forceinline__ float bfhi(unsigned u) { return __builtin_bit_cast(float, u & 0xffff0000u); }
__device__ __forceinline__ float wave_sum(float v) {
#pragma unroll
    for (int o = 1; o < 64; o <<= 1) v += __shfl_xor(v, o);
    return v;
}
__device__ __forceinline__ float sigmoidf_fast(float x) { return __builtin_amdgcn_rcpf(1.0f + __builtin_amdgcn_exp2f(-L2E * x)); }
__device__ __forceinline__ float gelu_tanh(float x) { const float z = 0.7978845608028654f * (x + 0.044715f * x * x * x); return x * sigmoidf_fast(2.0f * z); }

#define RLX_AGENT __ATOMIC_RELAXED, __HIP_MEMORY_SCOPE_AGENT
#define XB_TMO      128
#define XB_XCNT(j)  (256  + 64 * (j))
#define XB_XSUB(j)  (1280 + 64 * (j))
#define XB_XGEN(j)  (2304 + 64 * (j))
#define XB_TOP      3328
#define XB_TOPGEN   3392
#define XCD_BAR_WORDS 3456
#define XB_SPIN_CAP (1u << 18)

__device__ __forceinline__ unsigned xb_ld(unsigned* p)              { return __hip_atomic_load(p, __ATOMIC_RELAXED, __HIP_MEMORY_SCOPE_AGENT); }
__device__ __forceinline__ unsigned xb_add(unsigned* p, unsigned v) { return __hip_atomic_fetch_add(p, v, __ATOMIC_RELAXED, __HIP_MEMORY_SCOPE_AGENT); }
__device__ __forceinline__ unsigned xb_xcc_id() { return (unsigned)__builtin_amdgcn_s_getreg((3 << 11) | 20) & 0xFu; }
#define XB_SPIN(cond, bar) do { unsigned _sp = 0; while (cond) { __builtin_amdgcn_s_sleep(1); \
    if ((++_sp & 255u) == 0u) { if (xb_ld(&(bar)[XB_TMO])) break; if (_sp > XB_SPIN_CAP) { atomicAdd(&(bar)[XB_TMO], 1u); break; } } } } while (0)

struct XcdBarrier {
    unsigned* bar; unsigned x;
    volatile LAS unsigned* st;
};

__device__ __forceinline__ XcdBarrier xcd_barrier_post(unsigned* bar, volatile LAS unsigned* st) {
    XcdBarrier b; b.bar = bar; b.x = xb_xcc_id(); b.st = st;
    if (threadIdx.x == 0) (void)xb_add(&bar[XB_XCNT(b.x)], 1u);
    return b;
}
__device__ __forceinline__ void xcd_barrier_complete(unsigned* bar, unsigned x, unsigned& nloc, unsigned& nx) {
    const unsigned G = gridDim.x * gridDim.y * gridDim.z;
    unsigned sum, cnt, mine, sp = 0u;
    for (;;) {
        sum = 0u; cnt = 0u; mine = 0u;
#pragma unroll
        for (unsigned j = 0; j < 16; ++j) { const unsigned c = xb_ld(&bar[XB_XCNT(j)]); sum += c; cnt += (c > 0u) ? 1u : 0u; mine = (j == x) ? c : mine; }
        if (sum == G) break;
        __builtin_amdgcn_s_sleep(1);
        if ((++sp & 255u) == 0u) { if (xb_ld(&bar[XB_TMO])) break; if (sp > XB_SPIN_CAP) { atomicAdd(&bar[XB_TMO], 1u); break; } }
    }
    nloc = mine > 0u ? mine : 1u; nx = cnt > 0u ? cnt : 1u;
}

__device__ __forceinline__ void xcd_barrier(const XcdBarrier& b) {
    asm volatile("s_waitcnt vmcnt(0)" ::: "memory");
    __syncthreads();
    if (threadIdx.x == 0) {
        unsigned* bar = b.bar;
        __builtin_amdgcn_s_waitcnt(0);
        unsigned nloc = b.st[0], nx = b.st[1];
        if (nloc == 0u) { xcd_barrier_complete(bar, b.x, nloc, nx); b.st[0] = nloc; b.st[1] = nx; }
        const unsigned old = xb_add(&bar[XB_XSUB(b.x)], 1u);
        const unsigned gen = old / nloc;
        if (old + 1u == (gen + 1u) * nloc) {
            __builtin_amdgcn_fence(__ATOMIC_RELEASE, "agent");
            asm volatile("s_waitcnt vmcnt(0)" ::: "memory");
            const unsigned og = xb_add(&bar[XB_TOP], 1u);
            const unsigned tg = og / nx;
            if (og + 1u == (tg + 1u) * nx) xb_add(&bar[XB_TOPGEN], 1u);
            else XB_SPIN(xb_ld(&bar[XB_TOPGEN]) == tg, bar);
            __builtin_amdgcn_fence(__ATOMIC_ACQUIRE, "agent");
            xb_add(&bar[XB_XGEN(b.x)], 1u);
            asm volatile("s_waitcnt vmcnt(0)" ::: "memory");
        } else {
            XB_SPIN(xb_ld(&bar[XB_XGEN(b.x)]) == gen, bar);
            __builtin_amdgcn_fence(__ATOMIC_ACQUIRE, "agent");
            asm volatile("s_waitcnt vmcnt(0)" ::: "memory");
        }
    }
    __syncthreads();
}

__device__ __forceinline__ void p0_transpose_item(const float* W, int K, int N, bf16* WT, int k0, int n0, int drow0, const float* kscale, LAS float* scr, int lane) {
    { const int r8 = lane >> 3, c4 = (lane & 7) * 4; f32x4 v[8];
#pragma unroll
      for (int i = 0; i < 8; ++i) v[i] = __builtin_nontemporal_load((const f32x4*)(W + (size_t)(k0 + 8 * i + r8) * N + n0 + c4));
#pragma unroll
      for (int i = 0; i < 8; ++i) { const int kk = 8 * i + r8; f32x4 w = v[i]; if (kscale) w = w * kscale[k0 + kk]; LAS float* d = scr + kk * 33 + c4; d[0] = w.x; d[1] = w.y; d[2] = w.z; d[3] = w.w; } }
    LDS_WAIT(); asm volatile("" ::: "memory");
    const int c = lane & 7;
#pragma unroll
    for (int j = 0; j < 4; ++j) { const int n = (lane >> 3) + 8 * j; const LAS float* s = scr + (8 * c) * 33 + n;
        v4u o; o.x = pk2(s[0 * 33], s[1 * 33]); o.y = pk2(s[2 * 33], s[3 * 33]); o.z = pk2(s[4 * 33], s[5 * 33]); o.w = pk2(s[6 * 33], s[7 * 33]);
        *(v4u*)(WT + (size_t)(drow0 + n) * K + k0 + 8 * c) = o; }
    LDS_WAIT(); asm volatile("" ::: "memory");
}
struct Ptrs {
    const float *x, *norm_mix, *w_in, *q_norm, *k_norm, *conv_w, *conv_b, *w_rgate, *b_rgate, *w_igate, *b_igate, *lam, *on_attn, *on_lru, *w_out, *norm_ffn, *w_gate, *w_up, *w_down;
    float* out; float* ssq; float* ssqa; bf16 *Win_t, *Wout_t, *Wgu_t, *Wd_t, *XN, *PROJ, *ATT, *YF, *YB, *FF;
};
constexpr int P0_I_IN = 16 * 56, P0_NITEMS = 16 * 56 + 16 * 32 + 2 * 16 * 88 + 44 * 32;
__device__ __forceinline__ void p0_transposes(const Ptrs& F, LAS unsigned char* lds, int gw, int NGW, int wave, int lane, int it0, int it1) {
    LAS float* scr = (LAS float*)(lds + wave * 16384);
    constexpr int I_IN = 16 * 56, I_OUT = 16 * 32, I_G = 16 * 88, I_D = 44 * 32, NITEMS = I_IN + I_OUT + 2 * I_G + I_D;
    for (int it = gw + it0; it < it1; it += NGW) {
        int r = it;
        if (r < I_IN) { const int kb = r / 56, nb = r % 56; p0_transpose_item(F.w_in, 1024, 1792, F.Win_t, 64 * kb, 32 * nb, 32 * nb, nullptr, scr, lane); continue; } r -= I_IN;
        if (r < I_OUT) { const int kb = r / 32, nb = r % 32; p0_transpose_item(F.w_out, 1024, 1024, F.Wout_t, 64 * kb, 32 * nb, 32 * nb, kb < 8 ? F.on_attn : nullptr, scr, lane); continue; } r -= I_OUT;
        if (r < I_G) { const int kb = r / 88, nb = r % 88, n0 = 32 * nb; p0_transpose_item(F.w_gate, 1024, 2816, F.Wgu_t, 64 * kb, n0, 256 * (n0 >> 7) + (n0 & 127), F.norm_ffn, scr, lane); continue; } r -= I_G;
        if (r < I_G) { const int kb = r / 88, nb = r % 88, n0 = 32 * nb; p0_transpose_item(F.w_up, 1024, 2816, F.Wgu_t, 64 * kb, n0, 256 * (n0 >> 7) + (n0 & 127) + 128, F.norm_ffn, scr, lane); continue; } r -= I_G;
        { const int kb = r / 32, nb = r % 32; p0_transpose_item(F.w_down, 2816, 1024, F.Wd_t, 64 * kb, 32 * nb, 32 * nb, nullptr, scr, lane); }
    }
}
__device__ __forceinline__ void p0_xn(const Ptrs& F, int gw, int NGW, int lane) {
    f32x4 g[4];
#pragma unroll
    for (int j = 0; j < 4; ++j) g[j] = ((const f32x4*)F.norm_mix)[lane + 64 * j];
    const int R_ = (M % NGW == 0) ? M / NGW : 0, base_ = R_ ? gw * R_ : gw, stride_ = R_ ? 1 : NGW, cnt_ = R_ ? R_ : ((gw < M) ? (M - gw + NGW - 1) / NGW : 0);
    f32x4 nx[4], ny[4];
    if (0 < cnt_) { const f32x4* xr = (const f32x4*)(F.x + (size_t)base_ * DMODEL) + lane;
#pragma unroll
        for (int j = 0; j < 4; ++j) nx[j] = __builtin_nontemporal_load(xr + 64 * j); }
    if (1 < cnt_) { const f32x4* xr = (const f32x4*)(F.x + (size_t)(base_ + stride_) * DMODEL) + lane;
#pragma unroll
        for (int j = 0; j < 4; ++j) ny[j] = __builtin_nontemporal_load(xr + 64 * j); }
    for (int k = 0; k < cnt_; ++k) { const int m = base_ + k * stride_;
        f32x4 v[4]; float s = 0.f;
#pragma unroll
        for (int j = 0; j < 4; ++j) { v[j] = nx[j]; nx[j] = ny[j]; }
        if (k + 2 < cnt_) { const f32x4* xr = (const f32x4*)(F.x + (size_t)(base_ + (k + 2) * stride_) * DMODEL) + lane;
#pragma unroll
            for (int j = 0; j < 4; ++j) ny[j] = __builtin_nontemporal_load(xr + 64 * j); }
#pragma unroll
        for (int j = 0; j < 4; ++j) s += (v[j].x * v[j].x + v[j].y * v[j].y) + (v[j].z * v[j].z + v[j].w * v[j].w);
        const float rstd = 1.0f / sqrtf(wave_sum(s) * (1.0f / DMODEL) + EPS);
        v2u* o8 = (v2u*)(F.XN + (size_t)m * DMODEL) + lane;
#pragma unroll
        for (int j = 0; j < 4; ++j) { v2u w; w.x = pk2(v[j].x * rstd * g[j].x, v[j].y * rstd * g[j].y); w.y = pk2(v[j].z * rstd * g[j].z, v[j].w * rstd * g[j].w); o8[64 * j] = w; }
    }
    for (int i = gw * 64 + lane; i < M; i += NGW * 64) { F.ssq[i] = 0.f; F.ssqa[i] = 0.f; }
}

constexpr int NKP = M * 2 / 16;
__device__ __forceinline__ void rope_table(LAS unsigned char* lds, int off, int tid) {
    LAS float* TC = (LAS float*)(lds + off); LAS float* TS = TC + 1024;
    for (int idx = tid; idx < 1024; idx += NWAVES * 64) { const int pos = idx >> 4, j = idx & 15; const float inv = exp2f(-(float)j * (13.287712379549449f / 16.0f));
        float rev = (float)pos * inv * 0.15915494309189535f; rev -= floorf(rev); TC[idx] = __builtin_amdgcn_cosf(rev); TS[idx] = __builtin_amdgcn_sinf(rev); }
    __syncthreads();
}
__device__ __forceinline__ void k_pass(const Ptrs& F, bf16* DST, LAS unsigned char* lds, int gw, int NGW, int tid, int lane) {
    const int sub = lane & 3, hl = lane >> 2;
    v2u pre0[4], pre1[4];
#pragma unroll
    for (int qd = 0; qd < 4; ++qd) { pre0[qd] = (v2u){0u, 0u}; pre1[qd] = (v2u){0u, 0u}; }
    if (gw < NKP) { const int hidx = gw * 16 + hl, m = hidx >> 1, hh = 8 + (hidx & 1); const bf16* p = F.PROJ + (size_t)m * D_IN + hh * 64 + 4 * sub;
#pragma unroll
        for (int qd = 0; qd < 4; ++qd) pre0[qd] = *(const v2u*)(p + 16 * qd); }
    if (gw + NGW < NKP) { const int hidx = (gw + NGW) * 16 + hl, m = hidx >> 1, hh = 8 + (hidx & 1); const bf16* p = F.PROJ + (size_t)m * D_IN + hh * 64 + 4 * sub;
#pragma unroll
        for (int qd = 0; qd < 4; ++qd) pre1[qd] = *(const v2u*)(p + 16 * qd); }
    rope_table(lds, 0, tid);
    const LAS float* TC = (const LAS float*)lds; const LAS float* TS = TC + 1024;
    int jstep = 0;
    for (int it = gw; it < NKP; it += NGW, ++jstep) {
        const int hidx = it * 16 + hl, m = hidx >> 1, hh = 8 + (hidx & 1);
        const bf16* p = F.PROJ + (size_t)m * D_IN + hh * 64 + 4 * sub;
        v2u raw[4]; float v[4][4]; float s = 0.f;
        if (jstep == 0) {
#pragma unroll
            for (int qd = 0; qd < 4; ++qd) raw[qd] = pre0[qd];
        } else if (jstep == 1) {
#pragma unroll
            for (int qd = 0; qd < 4; ++qd) raw[qd] = pre1[qd];
        } else {
#pragma unroll
            for (int qd = 0; qd < 4; ++qd) raw[qd] = *(const v2u*)(p + 16 * qd);
        }
#pragma unroll
        for (int qd = 0; qd < 4; ++qd) { v[qd][0] = bflo(raw[qd].x); v[qd][1] = bfhi(raw[qd].x); v[qd][2] = bflo(raw[qd].y); v[qd][3] = bfhi(raw[qd].y);
            s += (v[qd][0] * v[qd][0] + v[qd][1] * v[qd][1]) + (v[qd][2] * v[qd][2] + v[qd][3] * v[qd][3]); }
        s += __shfl_xor(s, 1); s += __shfl_xor(s, 2);
        const float rstd = 1.0f / sqrtf(s * (1.0f / 64.0f) + EPS);
#pragma unroll
        for (int qd = 0; qd < 4; ++qd) { const f32x4 gv = *(const f32x4*)(F.k_norm + 16 * qd + 4 * sub);
#pragma unroll
            for (int e = 0; e < 4; ++e) v[qd][e] = v[qd][e] * rstd * gv[e]; }
        const int t = m & (SEQ - 1), prow = t >> 6, pcol = t & 63;
        const f32x4 cr = *(const LAS f32x4*)(TC + prow * 16 + 4 * sub), sr = *(const LAS f32x4*)(TS + prow * 16 + 4 * sub);
        const f32x4 cc = *(const LAS f32x4*)(TC + pcol * 16 + 4 * sub), sc = *(const LAS f32x4*)(TS + pcol * 16 + 4 * sub);
        float o[4][4];
#pragma unroll
        for (int e = 0; e < 4; ++e) { o[0][e] = v[0][e] * cr[e] - v[1][e] * sr[e]; o[1][e] = v[1][e] * cr[e] + v[0][e] * sr[e];
            o[2][e] = v[2][e] * cc[e] - v[3][e] * sc[e]; o[3][e] = v[3][e] * cc[e] + v[2][e] * sc[e]; }
        bf16* q = DST + (size_t)m * D_IN + hh * 64 + 4 * sub;
#pragma unroll
        for (int qd = 0; qd < 4; ++qd) { v2u w; w.x = pk2(o[qd][0], o[qd][1]); w.y = pk2(o[qd][2], o[qd][3]); *(v2u*)(q + 16 * qd) = w; }
    }
    __syncthreads();
}

namespace lru {
constexpr int XA_OFF = 0, XA_PITCH = 144, XA_BYTES = 128 * 144, PY_OFF = 2 * XA_BYTES, PY_BYTES = 4 * 64 * 2 * 4, CW_OFF = PY_OFF + 2 * PY_BYTES, YS_OFF = CW_OFF + 1280, YS_BYTES = 128 * 128;
__device__ __forceinline__ int crow(int r, int hi) { return (r & 3) + 8 * (r >> 2) + 4 * hi; }
}
__device__ __forceinline__ void lru_item(const Ptrs& F, LAS unsigned char* lds, int b, int nb, int dir, int tid, int lane, int wave) {
    using namespace lru;
    const int hi = lane >> 5, n32 = lane & 31, tq = wave >> 1, chh = wave & 1;
    const int cl_ = 32 * chh + n32, C = dir * 512 + 64 * nb + cl_;
    bf16x8 Br[4], Bi[4];
    { const float* wr_p = F.w_rgate + (size_t)(dir * 8 + nb) * 4096 + cl_; const float* wi_p = F.w_igate + (size_t)(dir * 8 + nb) * 4096 + cl_;
#pragma unroll
      for (int ks = 0; ks < 4; ++ks)
#pragma unroll
          for (int j = 0; j < 8; ++j) { const int k = 16 * ks + 8 * hi + j; Br[ks][j] = (short)f2bf(wr_p[k * 64]); Bi[ks][j] = (short)f2bf(wi_p[k * 64]); } }
    const float brn = -L2E * F.b_rgate[C], bin = -L2E * F.b_igate[C];
    const float nl = -F.lam[C];
    const float sp = fmaxf(nl, 0.f) + log1pf(expf(-fabsf(nl)));
    const float cl2 = -8.0f * sp * L2E;
    const int p0 = tid >> 3, c8 = (tid & 7) * 8;
    LAS float* CW = (LAS float*)(lds + CW_OFF);
    if (tid < 320) CW[tid] = (tid < 256) ? F.conv_w[(tid >> 6) * 512 + 64 * nb + (tid & 63)] : F.conv_b[64 * nb + (tid & 63)];
    const bf16* xl = F.PROJ + (size_t)b * SEQ * D_IN + COL_XL + 64 * nb + c8;
    bf16* Yb = (dir ? F.YB : F.YF) + (size_t)b * SEQ * 512 + 64 * nb;
#define LRU_FLUSH(ck_) do { const LAS unsigned char* ys_ = lds + YS_OFF + ((ck_) & 1) * YS_BYTES; \
        _Pragma("unroll") for (int j_ = 0; j_ < 2; ++j_) { const int q_ = tid + 512 * j_, p_ = q_ >> 3, sg_ = q_ & 7; const v4u v_ = *(const LAS v4u*)(ys_ + p_ * 128 + sg_ * 16); \
            const int P_ = 128 * (ck_) + p_, t_ = dir ? (SEQ - 1 - P_) : P_; __builtin_nontemporal_store(v_, (v4u*)(Yb + (size_t)t_ * 512 + sg_ * 8)); } } while (0)
    float H = 0.f;
#define LRU_BAR() asm volatile("s_waitcnt lgkmcnt(0)\n\ts_barrier" ::: "memory")
#define LRU_LOAD(ck_) do { _Pragma("unroll") for (int half = 0; half < 2; ++half) { const int P_ = 128 * (ck_) + p0 + 64 * half, t_ = dir ? (SEQ - 1 - P_) : P_; \
        _Pragma("unroll") for (int tap = 0; tap < 4; ++tap) { const int tr = t_ - 1 + tap; raw[half][tap] = (tr >= 0 && tr < SEQ) ? *(const v4u*)(xl + (size_t)tr * D_IN) : (v4u){0u, 0u, 0u, 0u}; } } } while (0)
#define LRU_CONV(buf_) do { float cw[4][8], cb[8]; \
        _Pragma("unroll") for (int tap = 0; tap < 5; ++tap) { const f32x4 u0 = *(const LAS f32x4*)(CW + tap * 64 + c8), u1 = *(const LAS f32x4*)(CW + tap * 64 + c8 + 4); \
            float* d = (tap < 4) ? cw[tap < 4 ? tap : 0] : cb; d[0] = u0.x; d[1] = u0.y; d[2] = u0.z; d[3] = u0.w; d[4] = u1.x; d[5] = u1.y; d[6] = u1.z; d[7] = u1.w; } \
        _Pragma("unroll") for (int half = 0; half < 2; ++half) { const int pp = p0 + 64 * half; float a[8]; \
            _Pragma("unroll") for (int j = 0; j < 8; ++j) a[j] = cb[j]; \
            _Pragma("unroll") for (int tap = 0; tap < 4; ++tap) { const v4u rw = raw[half][tap]; \
                a[0] += cw[tap][0] * bflo(rw.x); a[1] += cw[tap][1] * bfhi(rw.x); a[2] += cw[tap][2] * bflo(rw.y); a[3] += cw[tap][3] * bfhi(rw.y); \
                a[4] += cw[tap][4] * bflo(rw.z); a[5] += cw[tap][5] * bfhi(rw.z); a[6] += cw[tap][6] * bflo(rw.w); a[7] += cw[tap][7] * bfhi(rw.w); } \
            v4u w; w.x = pk2(a[0], a[1]); w.y = pk2(a[2], a[3]); w.z = pk2(a[4], a[5]); w.w = pk2(a[6], a[7]); \
            *(LAS v4u*)(lds + XA_OFF + (buf_) * XA_BYTES + pp * XA_PITCH + c8 * 2) = w; } } while (0)
    v4u raw[2][4];
    LRU_LOAD(0);
    __syncthreads();
    LRU_CONV(0);
    LRU_LOAD(1);
    LRU_BAR();
    for (int ck = 0; ck < SEQ / 128; ++ck) {
        const LAS unsigned char* xa = lds + XA_OFF + (ck & 1) * XA_BYTES;
        LAS float* PY = (LAS float*)(lds + PY_OFF + (ck & 1) * PY_BYTES);
        f32x16 dr = {}, di = {};
#pragma unroll
        for (int ks = 0; ks < 4; ++ks) { const bf16x8 A = *(const LAS bf16x8*)(xa + (32 * tq + n32) * XA_PITCH + (16 * ks + 8 * hi) * 2);
            dr = __builtin_amdgcn_mfma_f32_32x32x16_bf16(A, Br[ks], dr, 0, 0, 0); di = __builtin_amdgcn_mfma_f32_32x32x16_bf16(A, Bi[ks], di, 0, 0, 0); }
        float pc[16], yl[16];
#pragma unroll
        for (int r = 0; r < 16; ++r) { const int p = 32 * tq + crow(r, hi); const float xcv = __builtin_bit_cast(float, (unsigned)(*(const LAS unsigned short*)(xa + p * XA_PITCH + cl_ * 2)) << 16);
            const float rg = __builtin_amdgcn_rcpf(1.0f + __builtin_amdgcn_exp2f(__builtin_fmaf(dr[r], -L2E, brn))), ig = __builtin_amdgcn_rcpf(1.0f + __builtin_amdgcn_exp2f(__builtin_fmaf(di[r], -L2E, bin)));
            const float a = __builtin_amdgcn_exp2f(rg * cl2); const float om = __builtin_fmaf(-a, a, 1.0f);
            const float x = __builtin_amdgcn_sqrtf(om) * ig * xcv;
            if ((r & 3) == 0) { pc[r] = a; yl[r] = x; } else { pc[r] = a * pc[r - 1]; yl[r] = __builtin_fmaf(a, yl[r - 1], x); } }
        float Pm[4], Ym[4], Po[4], Yo[4];
#pragma unroll
        for (int g = 0; g < 4; ++g) { Pm[g] = pc[4 * g + 3]; Ym[g] = yl[4 * g + 3]; Po[g] = __shfl_xor(Pm[g], 32); Yo[g] = __shfl_xor(Ym[g], 32); }
        float E = 0.f, Q = 1.f, Eo[4], Qo[4];
#pragma unroll
        for (int g = 0; g < 4; ++g) {
            const float P0 = hi ? Po[g] : Pm[g], Y0 = hi ? Yo[g] : Ym[g], P1 = hi ? Pm[g] : Po[g], Y1 = hi ? Ym[g] : Yo[g];
            const float E1 = __builtin_fmaf(P0, E, Y0), Q1 = Q * P0;
            Eo[g] = hi ? E1 : E; Qo[g] = hi ? Q1 : Q;
            E = __builtin_fmaf(P1, E1, Y1); Q = Q1 * P1; }
        if (hi == 0) *(LAS f32x2v*)(PY + (tq * 64 + cl_) * 2) = (f32x2v){Q, E};
        __builtin_amdgcn_sched_barrier(0);
        if (ck + 1 < SEQ / 128) { LRU_CONV((ck + 1) & 1); if (ck + 2 < SEQ / 128) LRU_LOAD(ck + 2); }
        LRU_BAR();
        if (ck > 0) LRU_FLUSH(ck - 1);
        float cw_ = H, hall = H;
#pragma unroll
        for (int q2 = 0; q2 < 4; ++q2) { const f32x2v t2 = *(const LAS f32x2v*)(PY + (q2 * 64 + cl_) * 2); if (q2 == tq) cw_ = hall; hall = __builtin_fmaf(t2.x, hall, t2.y); }
        H = hall;
#pragma unroll
        for (int g = 0; g < 4; ++g) { const float cg = __builtin_fmaf(Qo[g], cw_, Eo[g]);
#pragma unroll
            for (int e = 0; e < 4; ++e) { const int r = 4 * g + e; const float y = __builtin_fmaf(pc[r], cg, yl[r]);
                *(LAS unsigned short*)(lds + YS_OFF + (ck & 1) * YS_BYTES + (32 * tq + crow(r, hi)) * 128 + cl_ * 2) = (unsigned short)f2bf(y); } }
    }
    LRU_BAR();
    LRU_FLUSH(SEQ / 128 - 1);
    __syncthreads();
#undef LRU_CONV
#undef LRU_FLUSH
}

struct CombRow { v4u yf, yb, gg; float sa; };
__device__ __forceinline__ void comb_load(const Ptrs& F, int row, int lane, CombRow& r) {
    r.yf = __builtin_nontemporal_load((const v4u*)(F.YF + (size_t)row * 512 + lane * 8)); r.yb = __builtin_nontemporal_load((const v4u*)(F.YB + (size_t)row * 512 + lane * 8));
    r.gg = __builtin_nontemporal_load((const v4u*)(F.PROJ + (size_t)row * D_IN + COL_GL + lane * 8)); r.sa = F.ssqa[row];
}
__device__ __forceinline__ void combine_pass(const Ptrs& F, bf16* MIX, int gw, int NGW, int lane) {
    const f32x4 gl0 = *(const f32x4*)(F.on_lru + lane * 8), gl1 = *(const f32x4*)(F.on_lru + lane * 8 + 4);
    CombRow n0, n1;
    if (gw < M) comb_load(F, gw, lane, n0);
    if (gw + NGW < M) comb_load(F, gw + NGW, lane, n1);
    for (int row = gw; row < M; row += NGW) {
        const CombRow c = n0; n0 = n1;
        if (row + 2 * NGW < M) comb_load(F, row + 2 * NGW, lane, n1);
        const v4u yf = c.yf, yb = c.yb, gg = c.gg; const float sa = c.sa;
        const float f[8] = {bflo(yf.x), bfhi(yf.x), bflo(yf.y), bfhi(yf.y), bflo(yf.z), bfhi(yf.z), bflo(yf.w), bfhi(yf.w)};
        const float bb[8] = {bflo(yb.x), bfhi(yb.x), bflo(yb.y), bfhi(yb.y), bflo(yb.z), bfhi(yb.z), bflo(yb.w), bfhi(yb.w)};
        const float g8[8] = {bflo(gg.x), bfhi(gg.x), bflo(gg.y), bfhi(gg.y), bflo(gg.z), bfhi(gg.z), bflo(gg.w), bfhi(gg.w)};
        float v[8]; float s = 0.f;
#pragma unroll
        for (int j = 0; j < 8; ++j) { v[j] = (f[j] + bb[j]) * gelu_tanh(g8[j]); s += v[j] * v[j]; }
        const float sc = sqrtf(sa * (1.0f / 512.0f) + EPS) / sqrtf(wave_sum(s) * (1.0f / 512.0f) + EPS);
        v4u w; w.x = pk2(v[0] * sc * gl0[0], v[1] * sc * gl0[1]); w.y = pk2(v[2] * sc * gl0[2], v[3] * sc * gl0[3]);
        w.z = pk2(v[4] * sc * gl1[0], v[5] * sc * gl1[1]); w.w = pk2(v[6] * sc * gl1[2], v[7] * sc * gl1[3]);
        *(v4u*)(MIX + (size_t)row * 1024 + 512 + lane * 8) = w;
    }
}

struct Args { const float* in[19]; float* out; unsigned char* ws; int ph_lo, ph_hi; };
__global__ void __launch_bounds__(NWAVES * 64, 2) mk_fwd(Args args) {
    extern __shared__ __attribute__((aligned(16))) unsigned char lds[];
    LAS unsigned char* L = (LAS unsigned char*)lds;
    const int tid = threadIdx.x, lane = tid & 63, wave = __builtin_amdgcn_readfirstlane(tid >> 6);
    const int G = gridDim.x, bx = blockIdx.x;
    const int vcu = (G % 8 == 0) ? (bx % 8) * (G / 8) + bx / 8 : bx;
    const int gw = vcu * NWAVES + wave, NGW = G * NWAVES;
    unsigned char* ws = args.ws;
    Ptrs F;
    F.x = args.in[0]; F.norm_mix = args.in[1]; F.w_in = args.in[2]; F.q_norm = args.in[3]; F.k_norm = args.in[4]; F.conv_w = args.in[5]; F.conv_b = args.in[6];
    F.w_rgate = args.in[7]; F.b_rgate = args.in[8]; F.w_igate = args.in[9]; F.b_igate = args.in[10]; F.lam = args.in[11]; F.on_attn = args.in[12]; F.on_lru = args.in[13];
    F.w_out = args.in[14]; F.norm_ffn = args.in[15]; F.w_gate = args.in[16]; F.w_up = args.in[17]; F.w_down = args.in[18];
    F.out = args.out; F.ssq = (float*)(ws + WS_SSQ); F.ssqa = (float*)(ws + WS_SSQA);
    F.Win_t = (bf16*)(ws + WS_WIN); F.Wout_t = (bf16*)(ws + WS_WOUT); F.Wgu_t = (bf16*)(ws + WS_WGU); F.Wd_t = (bf16*)(ws + WS_WD);
    F.XN = (bf16*)(ws + WS_XN); F.PROJ = (bf16*)(ws + WS_PROJ); F.ATT = (bf16*)(ws + WS_ATT); F.YF = (bf16*)(ws + WS_YF); F.YB = (bf16*)(ws + WS_YB); F.FF = (bf16*)(ws + WS_FF);
    bf16* MIX = F.XN; bf16* H1B = (bf16*)(ws + WS_H1B);
    const int lo = args.ph_lo, hi = args.ph_hi;
    volatile LAS unsigned* MISC = (volatile LAS unsigned*)(L + MISC_OFF);
    if (tid < 64) MISC[tid] = 0u;
    __syncthreads();
    XcdBarrier bar; bar.bar = (unsigned*)(ws + WS_CTL); bar.x = 0; bar.st = MISC + 8;
    if (hi - lo > 1) bar = xcd_barrier_post((unsigned*)(ws + WS_CTL), MISC + 8);
    if (hi > 1000) cooperative_groups::this_grid().sync();
#define IN(k) (lo <= (k) && (k) < hi)
#define SEAM(k) do { if (IN(k) && IN((k) + 1)) { xcd_barrier(bar); if (PROBE_DUP == 9) xcd_barrier(bar); } } while (0)

    if (IN(0)) REP(0) { p0_transposes(F, L, gw, NGW, wave, lane, 0, (G == 256 && hi > 1) ? P0_I_IN : P0_NITEMS); p0_xn(F, gw, NGW, lane); __syncthreads(); }
    SEAM(0);
    if (IN(1)) REP(1) { pg8::Gemm g{F.XN, F.Win_t, M, D_IN, DMODEL}; pg8::StaticOrder S; S.init(M, D_IN, G, bx); pg8::EpiStoreBf16 E{F.PROJ, D_IN};
        pg8::gemm_phase<pg8::EpiStoreBf16, pg8::StaticOrder, PG8_ALIGN, PG8_SP2>(L, g, S, E);
        if (G == 256 && lo == 0 && bx >= 128) { __syncthreads(); p0_transposes(F, L, (bx - 128) * NWAVES + wave, 128 * NWAVES, wave, lane, P0_I_IN, P0_NITEMS); } }
    SEAM(1);
    if (IN(2)) { k_pass(F, F.PROJ, L, gw, NGW, tid, lane);
        REP(2) for (int item = vcu; item < BATCH * 16; item += G) lru_item(F, L, item >> 4, (item >> 1) & 7, item & 1, tid, lane, wave); }
    SEAM(2);
    if (IN(3)) REP(3) { const attn_body::AttnTensors AT{(const attn_body::bf16*)F.PROJ, (const attn_body::bf16*)(F.PROJ + COL_K), (const attn_body::bf16*)(F.PROJ + COL_V), (attn_body::bf16*)MIX, F.q_norm, (const LAS float*)(L + ROPE_TAB_OFF), F.ssqa};
        if (tid < 128) ((LAS float*)(L + ROPE_TAB_OFF))[2048 + tid] = (tid < 64) ? F.q_norm[tid] : F.k_norm[tid - 64];
        rope_table(L, ROPE_TAB_OFF, tid);
        float mq = 0.f, mk = 0.f;
        for (int i = 0; i < 16; ++i) { const f32x4 a = ((const LAS f32x4*)(L + ROPE_TAB_OFF + 8192))[i], b2 = ((const LAS f32x4*)(L + ROPE_TAB_OFF + 8192 + 256))[i];
            mq = fmaxf(fmaxf(mq, fmaxf(fabsf(a.x), fabsf(a.y))), fmaxf(fabsf(a.z), fabsf(a.w))); mk = fmaxf(fmaxf(mk, fmaxf(fabsf(b2.x), fabsf(b2.y))), fmaxf(fabsf(b2.z), fabsf(b2.w))); }
        const bool nomax = __builtin_amdgcn_readfirstlane((11.55f * 1.05f * mq * mk < 40.0f) ? 1 : 0) != 0;
        attn_body::attn_phase<8>((char*)lds, AT, G, bx, nomax); }
    SEAM(3);
    if (IN(4)) REP(4) combine_pass(F, MIX, gw, NGW, lane);
    SEAM(4);
    if (IN(5)) REP(5) { pg8::Gemm g{MIX, F.Wout_t, M, DMODEL, DMODEL}; pg8::StaticOrder S; S.init(M, DMODEL, G, bx); pg8::EpiOutRes E{F.x, F.out, H1B, F.ssq, ((PROBE_MASK >> 5) & 1) ? 0.5f : 1.0f, F.ssqa, EPS, {}, {}};
        pg8::gemm_phase<pg8::EpiOutRes, pg8::StaticOrder, PG8_ALIGN, PG8_SP2>(L, g, S, E); }
    SEAM(5);
    if (IN(6)) REP(6) { pg8::Gemm g{H1B, F.Wgu_t, M, NGU, DMODEL}; pg8::StaticOrder S; S.init(M, NGU, G, bx); pg8::EpiSwiGLU E{F.ssq, F.FF, EPS, {}, {}};
        pg8::gemm_phase<pg8::EpiSwiGLU, pg8::StaticOrder, PG8_ALIGN, PG8_SP2>(L, g, S, E); }
    SEAM(6);
    if (IN(7)) REP(7) { pg8::Gemm g{F.FF, F.Wd_t, M, DMODEL, D_FF}; pg8::StaticOrder S; S.init(M, DMODEL, G, bx); pg8::EpiAccum E{F.out, H1B};
        pg8::gemm_phase<pg8::EpiAccum, pg8::StaticOrder, PG8_ALIGN, PG8_SP2>(L, g, S, E); }
#undef IN
#undef SEAM
}

extern "C" void kernel_launch(void* const* d_in, const int* in_sizes, int n_in, void* d_out, int out_size, void* d_ws, size_t ws_size, hipStream_t stream) {
    static int grid = 0;
    if (grid == 0) {
        if (n_in != 19 || in_sizes[0] != M * DMODEL || out_size != M * DMODEL || ws_size < WS_END) { fprintf(stderr, "kernel_launch: unexpected shapes (n_in %d, in0 %d, out %d, ws %zu)\n", n_in, n_in > 0 ? in_sizes[0] : -1, out_size, ws_size); grid = -1; return; }
        int dev = 0, cus = 0, per_cu = 0;
        hipGetDevice(&dev); hipDeviceGetAttribute(&cus, hipDeviceAttributeMultiprocessorCount, dev);
        if (hipFuncSetAttribute((const void*)mk_fwd, hipFuncAttributeMaxDynamicSharedMemorySize, LDS_BYTES) != hipSuccess) { fprintf(stderr, "kernel_launch: hipFuncSetAttribute failed\n"); }
        if (hipOccupancyMaxActiveBlocksPerMultiprocessor(&per_cu, (const void*)mk_fwd, NWAVES * 64, LDS_BYTES) != hipSuccess || per_cu < 1) { fprintf(stderr, "kernel_launch: occupancy query says %d\n", per_cu); per_cu = 1; }
        (void)hipGetLastError();
        if (per_cu > 1) per_cu = 1;
        grid = cus * per_cu;
    }
    if (grid < 0) return;
    if (hipMemsetAsync((char*)d_ws + WS_CTL, 0, CTL_ZERO_BYTES, stream) != hipSuccess) { fprintf(stderr, "kernel_launch: memset failed\n"); return; }
    Args a{};
    for (int i = 0; i < 19; ++i) a.in[i] = (const float*)d_in[i];
    a.out = (float*)d_out; a.ws = (unsigned char*)d_ws;
#if MK_LAUNCHES == 1
    a.ph_lo = 0; a.ph_hi = NPHASE;
    void* kargs[] = {&a};
    hipError_t e = hipLaunchCooperativeKernel((const void*)mk_fwd, dim3(grid), dim3(NWAVES * 64), kargs, LDS_BYTES, stream);
    if (e != hipSuccess) fprintf(stderr, "kernel_launch: cooperative launch failed: %s (grid %d)\n", hipGetErrorString(e), grid);
#else
    for (int ph = 0; ph < NPHASE; ++ph) { a.ph_lo = ph; a.ph_hi = ph + 1; hipLaunchKernelGGL(mk_fwd, dim3(grid), dim3(NWAVES * 64), LDS_BYTES, stream, a); }
#endif
}
```

```cpp
#include <hip/hip_runtime.h>
#include <hip/hip_cooperative_groups.h>
#include <cstdio>
#include <cstdint>
namespace pg8 {
#define PG8_LAS __attribute__((address_space(3)))
typedef unsigned short bf16_t;
typedef short bf16x8 __attribute__((ext_vector_type(8)));
typedef float f32x4 __attribute__((ext_vector_type(4)));
typedef unsigned u32x4 __attribute__((ext_vector_type(4)));
constexpr int BM = 256, BK = 64, HALF = 128, HTB = HALF * BK * 2  , STAGE_BYTES = 8 * HTB, NXCD = 8, WGM = 8;

__host__ __device__ __forceinline__ int lds_byte(int r, int c) { const int st = (r >> 4) * 2 + (c >> 5), rr = r & 15, cc = c & 31, ob = rr * 64 + cc * 2; return st * 1024 + (ob ^ (((ob >> 9) & 1) << 5)); }
__host__ __device__ __forceinline__ void stage_rc(int b, int& R, int& C) { const int st = b / 1024, sb = b % 1024, swz = sb ^ (((sb >> 9) & 1) << 5); R = (st >> 1) * 16 + swz / 64; C = (st & 1) * 32 + (swz % 64) / 2; }
__host__ __device__ __forceinline__ int perm32(int rho) { const int n = rho >> 4, i = rho & 15; return 8 * (i >> 2) + 4 * n + (i & 3); }

struct Unit { int pm, pn; };
struct Gemm { const bf16_t* A; const bf16_t* Bt; int M, N, K; };

struct StaticOrder {
    int nM, nN, nwg, G, c;
    __host__ __device__ void init(int M, int N, int G_, int c_) { nM = M / BM; nN = N / BM; nwg = nM * nN; G = G_; c = c_; }
    __host__ __device__ bool next(int i, Unit& u) const {
        const long L = (long)i * G + c; if (L >= nwg) return false;
        int wgid = (int)L; { const int q = nwg / NXCD, r = nwg % NXCD, xcd = wgid % NXCD, off = wgid / NXCD; wgid = (xcd < r ? xcd * (q + 1) : r * (q + 1) + (xcd - r) * q) + off; }
        const int nig = WGM * nN, gid = wgid / nig, fm = gid * WGM, gsz = (nM - fm) < WGM ? (nM - fm) : WGM;
        u.pm = fm + ((wgid % nig) % gsz); u.pn = (wgid % nig) / gsz; return true;
    }
    __device__ __forceinline__ void a_ready(const Unit&) const {}
    __device__ __forceinline__ void done(const Unit&) const {}
};

__device__ __forceinline__ unsigned cvt_pk_bf16(float lo, float hi) { unsigned r; asm volatile("v_cvt_pk_bf16_f32 %0, %1, %2" : "=v"(r) : "v"(lo), "v"(hi)); return r; }
typedef float f32x2 __attribute__((ext_vector_type(2)));
struct EpiStoreBf16 {
    __device__ __forceinline__ void prefetch(const Unit&, int, int) const {}
    __device__ __forceinline__ void rotate() const {}
    static constexpr bool PERM = true, AFTER_DRAIN = false;
    bf16_t* O; int ldc;
    __device__ __forceinline__ void operator()(const f32x4 (&acc)[2][2][4][2], const Unit& u, int wr, int wc, int fr, int fq) const {
        const int row0 = u.pm * BM + wr * 64 + fr, col0 = u.pn * BM + wc * 32 + 8 * fq;
#pragma unroll
        for (int ai = 0; ai < 2; ++ai)
#pragma unroll
            for (int m = 0; m < 4; ++m) { bf16_t* rowp = O + (size_t)(row0 + ai * HALF + m * 16) * ldc + col0;
#pragma unroll
                for (int bj = 0; bj < 2; ++bj) { const f32x4 v0 = acc[ai][bj][m][0], v1 = acc[ai][bj][m][1];
                    u32x4 w; w.x = cvt_pk_bf16(v0[0], v0[1]); w.y = cvt_pk_bf16(v0[2], v0[3]); w.z = cvt_pk_bf16(v1[0], v1[1]); w.w = cvt_pk_bf16(v1[2], v1[3]);
                    *(u32x4*)(rowp + bj * HALF) = w; } }
    }
};
struct EpiOutRes {
    static constexpr bool PERM = true, AFTER_DRAIN = false;
    const float* X; float* OUT; bf16_t* HB; float* ssq; float sscale; const float* ssqa; float eps; mutable float pre[2][4], nxv[2][4];
    __device__ __forceinline__ void rotate() const {
#pragma unroll
        for (int ai = 0; ai < 2; ++ai)
#pragma unroll
            for (int m = 0; m < 4; ++m) pre[ai][m] = nxv[ai][m];
    }
    __device__ __forceinline__ void prefetch(const Unit& u, int wr, int fr) const {
        const int row0 = u.pm * BM + wr * 64 + fr;
#pragma unroll
        for (int ai = 0; ai < 2; ++ai)
#pragma unroll
            for (int m = 0; m < 4; ++m) nxv[ai][m] = ssqa[row0 + ai * HALF + m * 16];
    }
    __device__ __forceinline__ void operator()(const f32x4 (&acc)[2][2][4][2], const Unit& u, int wr, int wc, int fr, int fq) const {
        const int row0 = u.pm * BM + wr * 64 + fr, col0 = u.pn * BM + wc * 32 + 8 * fq;
#pragma unroll
        for (int ai = 0; ai < 2; ++ai)
#pragma unroll
            for (int m = 0; m < 4; ++m) { const int row = row0 + ai * HALF + m * 16; const size_t off = (size_t)row * 1024 + col0; float s = 0.f; const float ra = __builtin_amdgcn_rsqf(pre[ai][m] * (1.0f / 512.0f) + eps);
#pragma unroll
                for (int bj = 0; bj < 2; ++bj) { const f32x4 x0 = __builtin_nontemporal_load((const f32x4*)(X + off + bj * HALF)), x1 = __builtin_nontemporal_load((const f32x4*)(X + off + bj * HALF + 4));
                    const f32x4 v0 = acc[ai][bj][m][0] * ra + x0, v1 = acc[ai][bj][m][1] * ra + x1;
                    s += (v0[0] * v0[0] + v0[1] * v0[1]) + (v0[2] * v0[2] + v0[3] * v0[3]) + (v1[0] * v1[0] + v1[1] * v1[1]) + (v1[2] * v1[2] + v1[3] * v1[3]);
                    u32x4 w; w.x = cvt_pk_bf16(v0[0], v0[1]); w.y = cvt_pk_bf16(v0[2], v0[3]); w.z = cvt_pk_bf16(v1[0], v1[1]); w.w = cvt_pk_bf16(v1[2], v1[3]);
                    *(u32x4*)(HB + off + bj * HALF) = w; }
                s += __shfl_xor(s, 16); s += __shfl_xor(s, 32);
                if (fq == 0) unsafeAtomicAdd(ssq + row, s * sscale); }
    }
};
struct EpiSwiGLU {
    static constexpr bool PERM = true, AFTER_DRAIN = false;
    const float* ssq; bf16_t* FF; float eps; mutable float pre[2][4], nxv[2][4];
    __device__ __forceinline__ void rotate() const {
#pragma unroll
        for (int ai = 0; ai < 2; ++ai)
#pragma unroll
            for (int m = 0; m < 4; ++m) pre[ai][m] = nxv[ai][m];
    }
    __device__ __forceinline__ void prefetch(const Unit& u, int wr, int fr) const {
        const int row0 = u.pm * BM + wr * 64 + fr;
#pragma unroll
        for (int ai = 0; ai < 2; ++ai)
#pragma unroll
            for (int m = 0; m < 4; ++m) nxv[ai][m] = ssq[row0 + ai * HALF + m * 16];
    }
    __device__ __forceinline__ void operator()(const f32x4 (&acc)[2][2][4][2], const Unit& u, int wr, int wc, int fr, int fq) const {
        const int row0 = u.pm * BM + wr * 64 + fr, col0 = u.pn * HALF + wc * 32 + 8 * fq;
#pragma unroll
        for (int ai = 0; ai < 2; ++ai)
#pragma unroll
            for (int m = 0; m < 4; ++m) { const int row = row0 + ai * HALF + m * 16; const float rstd = __builtin_amdgcn_rsqf(pre[ai][m] * (1.0f / 1024.0f) + eps);
                const float k1 = -1.4426950408889634f * rstd, r2 = rstd * rstd;
                unsigned wv[4];
#pragma unroll
                for (int n = 0; n < 2; ++n)
#pragma unroll
                    for (int h = 0; h < 2; ++h) { const f32x2 g2 = {acc[ai][0][m][n][2 * h], acc[ai][0][m][n][2 * h + 1]}, u2 = {acc[ai][1][m][n][2 * h], acc[ai][1][m][n][2 * h + 1]};
                        const f32x2 t = g2 * k1; f32x2 e; e.x = __builtin_amdgcn_exp2f(t.x); e.y = __builtin_amdgcn_exp2f(t.y);
                        const f32x2 d = e + 1.0f; f32x2 r; r.x = __builtin_amdgcn_rcpf(d.x); r.y = __builtin_amdgcn_rcpf(d.y);
                        const f32x2 o = (g2 * u2) * (r * r2); wv[n * 2 + h] = cvt_pk_bf16(o.x, o.y); }
                u32x4 w; w.x = wv[0]; w.y = wv[1]; w.z = wv[2]; w.w = wv[3];
                *(u32x4*)(FF + (size_t)row * 2816 + col0) = w; }
    }
};
struct EpiAccum {
    __device__ __forceinline__ void prefetch(const Unit&, int, int) const {}
    __device__ __forceinline__ void rotate() const {}
    static constexpr bool PERM = true, AFTER_DRAIN = false;
    float* OUT; const bf16_t* HB;
    __device__ __forceinline__ void operator()(const f32x4 (&acc)[2][2][4][2], const Unit& u, int wr, int wc, int fr, int fq) const {
        const int row0 = u.pm * BM + wr * 64 + fr, col0 = u.pn * BM + wc * 32 + 8 * fq;
#pragma unroll
        for (int ai = 0; ai < 2; ++ai)
#pragma unroll
            for (int m = 0; m < 4; ++m) { const size_t off = (size_t)(row0 + ai * HALF + m * 16) * 1024 + col0;
#pragma unroll
                for (int bj = 0; bj < 2; ++bj) { f32x4* p0 = (f32x4*)(OUT + off + bj * HALF); const u32x4 h = *(const u32x4*)(HB + off + bj * HALF);
                    const f32x4 x0 = {__builtin_bit_cast(float, h.x << 16), __builtin_bit_cast(float, h.x & 0xffff0000u), __builtin_bit_cast(float, h.y << 16), __builtin_bit_cast(float, h.y & 0xffff0000u)};
                    const f32x4 x1 = {__builtin_bit_cast(float, h.z << 16), __builtin_bit_cast(float, h.z & 0xffff0000u), __builtin_bit_cast(float, h.w << 16), __builtin_bit_cast(float, h.w & 0xffff0000u)};
                    __builtin_nontemporal_store(acc[ai][bj][m][0] + x0, p0); __builtin_nontemporal_store(acc[ai][bj][m][1] + x1, p0 + 1); } }
    }
};

template <class Epi, class Sched, bool ALIGN_EPI = false, bool SP2 = false>
__device__ __forceinline__ void gemm_phase(PG8_LAS unsigned char* lds, const Gemm g, const Sched& S, const Epi& E) {
    const int tid = threadIdx.x, wid = __builtin_amdgcn_readfirstlane(tid >> 6), lane = tid & 63, wr = wid >> 2, wc = wid & 3, fr = lane & 15, fq = lane >> 4;
    const int K = g.K, nt = K / BK;
    unsigned voffA[2], voffB[2];
#pragma unroll
    for (int i = 0; i < 2; ++i) { int R, C; stage_rc(tid * 16 + i * 8192, R, C); const int Rb = Epi::PERM ? ((R & ~31) + perm32(R & 31)) : R;
        voffA[i] = (unsigned)(R * K + C) * 2u; voffB[i] = (unsigned)(Rb * K + C) * 2u; }
    const size_t kstep = (size_t)(BK * 2);
    const size_t hstep = (size_t)HALF * K * 2;
    const size_t tstep = 2 * hstep;
    const unsigned ldsw = (unsigned)wid * 1024u;
    const int aoff = lds_byte(wr * 64 + fr, fq * 8), boff = lds_byte(wc * 32 + fr, fq * 8);
#define PG8_SA(b, h) (((b) * 2 + (h)) * HTB)
#define PG8_SB(b, h) ((4 + (b) * 2 + (h)) * HTB)
#define PG8_STAGE(bufoff, gbase, voff) do { _Pragma("unroll") for (int _i = 0; _i < 2; ++_i) \
        __builtin_amdgcn_global_load_lds((const unsigned*)((const char*)(gbase) + (voff)[_i]), (PG8_LAS unsigned*)(lds + (bufoff) + ldsw + _i * 8192), 16, 0, 0); } while (0)
#define PG8_LDA(dst, b, h) do { _Pragma("unroll") for (int m = 0; m < 4; ++m) _Pragma("unroll") for (int k = 0; k < 2; ++k) dst[m][k] = *(const PG8_LAS bf16x8*)(lds + PG8_SA(b, h) + aoff + m * 2048 + k * 1024); } while (0)
#define PG8_LDB(dst, b, h) do { _Pragma("unroll") for (int n = 0; n < 2; ++n) _Pragma("unroll") for (int k = 0; k < 2; ++k) dst[n][k] = *(const PG8_LAS bf16x8*)(lds + PG8_SB(b, h) + boff + n * 2048 + k * 1024); } while (0)
#define PG8_MMA(ai, bj, At, Bt) do { __builtin_amdgcn_s_setprio(1); _Pragma("unroll") for (int m = 0; m < 4; ++m) _Pragma("unroll") for (int n = 0; n < 2; ++n) _Pragma("unroll") for (int k = 0; k < 2; ++k) \
        acc[ai][bj][m][n] = __builtin_amdgcn_mfma_f32_16x16x32_bf16(Bt[n][k], At[m][k], acc[ai][bj][m][n], 0, 0, 0); __builtin_amdgcn_s_setprio(0); } while (0)
#define PG8_WAIT_V(n) asm volatile("s_waitcnt vmcnt(" #n ")" ::: "memory")
#define PG8_WAIT_L(n) asm volatile("s_waitcnt lgkmcnt(" #n ")" ::: "memory")
#define PG8_BAR __builtin_amdgcn_s_barrier()
#define PG8_SCHED __builtin_amdgcn_sched_barrier(0)
    Unit cur, nxt; int ui = 0;
    if (!S.next(0, cur)) return;
    f32x4 acc[2][2][4][2];
#pragma unroll
    for (int a = 0; a < 2; ++a)
#pragma unroll
        for (int b = 0; b < 2; ++b)
#pragma unroll
            for (int m = 0; m < 4; ++m)
#pragma unroll
                for (int n = 0; n < 2; ++n) acc[a][b][m][n] = (f32x4){0.f, 0.f, 0.f, 0.f};
    bf16x8 At[4][2], B0[2][2], B1[2][2];
    const char* cA = (const char*)g.A + (size_t)cur.pm * tstep; const char* cB = (const char*)g.Bt + (size_t)cur.pn * tstep;
    S.a_ready(cur); E.prefetch(cur, wr, fr); E.rotate();
    if constexpr (SP2) {
        PG8_STAGE(PG8_SB(0, 0), cB, voffB); PG8_STAGE(PG8_SB(0, 1), cB + hstep, voffB); PG8_STAGE(PG8_SA(0, 0), cA, voffA); PG8_STAGE(PG8_SA(0, 1), cA + hstep, voffA);
        if (wr == 1) PG8_BAR;
        PG8_WAIT_V(2); PG8_BAR;
        PG8_STAGE(PG8_SB(1, 0), cB + kstep, voffB); PG8_STAGE(PG8_SA(1, 0), cA + kstep, voffA); PG8_STAGE(PG8_SB(1, 1), cB + hstep + kstep, voffB);
        PG8_WAIT_V(6); PG8_BAR;
    } else {
        PG8_STAGE(PG8_SB(0, 0), cB, voffB); PG8_STAGE(PG8_SA(0, 0), cA, voffA); PG8_STAGE(PG8_SB(0, 1), cB + hstep, voffB); PG8_STAGE(PG8_SA(0, 1), cA + hstep, voffA);
        if (wr == 1) PG8_BAR;
        PG8_WAIT_V(4); PG8_BAR;
        PG8_STAGE(PG8_SB(1, 0), cB + kstep, voffB); PG8_STAGE(PG8_SA(1, 0), cA + kstep, voffA); PG8_STAGE(PG8_SB(1, 1), cB + hstep + kstep, voffB);
        PG8_WAIT_V(6); PG8_BAR;
    }
    for (;;) {
        const bool has_next = S.next(ui + 1, nxt);
        const char* nA = has_next ? (const char*)g.A + (size_t)nxt.pm * tstep : cA; const char* nB = has_next ? (const char*)g.Bt + (size_t)nxt.pn * tstep : cB;
        for (int t = 0; t < nt; t += 2) {
            const bool last = (t == nt - 2);
            const char* a1 = cA + (size_t)(t + 1) * kstep;
            const char* a2 = last ? nA : cA + (size_t)(t + 2) * kstep; const char* b2 = last ? nB : cB + (size_t)(t + 2) * kstep;
            const char* a3 = a2 + kstep; const char* b3 = b2 + kstep;
            if (last && has_next) { S.a_ready(nxt); E.prefetch(nxt, wr, fr); }
            if constexpr (SP2) {
            PG8_LDB(B0, 0, 0); PG8_LDB(B1, 0, 1); PG8_SCHED; PG8_LDA(At, 0, 0); PG8_STAGE(PG8_SA(1, 1), a1 + hstep, voffA);
            PG8_WAIT_V(8); PG8_WAIT_L(0); PG8_BAR; PG8_MMA(0, 0, At, B0); PG8_MMA(0, 1, At, B1); PG8_BAR; PG8_SCHED;
            PG8_LDA(At, 0, 1); PG8_STAGE(PG8_SB(0, 0), b2, voffB); PG8_STAGE(PG8_SB(0, 1), b2 + hstep, voffB); PG8_STAGE(PG8_SA(0, 0), a2, voffA);
            PG8_WAIT_V(8); PG8_WAIT_L(0); PG8_BAR; PG8_MMA(1, 0, At, B0); PG8_MMA(1, 1, At, B1); PG8_BAR; PG8_SCHED;
            PG8_LDB(B0, 1, 0); PG8_LDB(B1, 1, 1); PG8_SCHED; PG8_LDA(At, 1, 0); PG8_STAGE(PG8_SA(0, 1), a2 + hstep, voffA);
            PG8_WAIT_V(8); PG8_WAIT_L(0); PG8_BAR; PG8_MMA(0, 0, At, B0); PG8_MMA(0, 1, At, B1); PG8_BAR; PG8_SCHED;
            PG8_LDA(At, 1, 1); PG8_STAGE(PG8_SB(1, 0), b3, voffB); PG8_STAGE(PG8_SB(1, 1), b3 + hstep, voffB); PG8_STAGE(PG8_SA(1, 0), a3, voffA);
            PG8_WAIT_V(8); PG8_WAIT_L(0); PG8_BAR; PG8_MMA(1, 0, At, B0); PG8_MMA(1, 1, At, B1); PG8_BAR; PG8_SCHED;
            } else {
            PG8_LDB(B0, 0, 0); PG8_SCHED; PG8_LDA(At, 0, 0); PG8_STAGE(PG8_SA(1, 1), a1 + hstep, voffA);
            PG8_WAIT_L(8); PG8_BAR; PG8_WAIT_L(0); PG8_MMA(0, 0, At, B0); PG8_BAR; PG8_SCHED;
            PG8_LDB(B1, 0, 1); PG8_STAGE(PG8_SB(0, 0), b2, voffB);
            PG8_BAR; PG8_WAIT_L(0); PG8_MMA(0, 1, At, B1); PG8_BAR;
            PG8_LDA(At, 0, 1); PG8_STAGE(PG8_SA(0, 0), a2, voffA);
            PG8_BAR; PG8_WAIT_L(0); PG8_MMA(1, 0, At, B0); PG8_BAR; PG8_SCHED;
            PG8_STAGE(PG8_SB(0, 1), b2 + hstep, voffB);
            PG8_WAIT_V(6); PG8_BAR; PG8_MMA(1, 1, At, B1); PG8_BAR;
            PG8_LDB(B0, 1, 0); PG8_SCHED; PG8_LDA(At, 1, 0); PG8_STAGE(PG8_SA(0, 1), a2 + hstep, voffA);
            PG8_WAIT_L(8); PG8_BAR; PG8_WAIT_L(0); PG8_MMA(0, 0, At, B0); PG8_BAR; PG8_SCHED;
            PG8_LDB(B1, 1, 1); PG8_STAGE(PG8_SB(1, 0), b3, voffB);
            PG8_BAR; PG8_WAIT_L(0); PG8_MMA(0, 1, At, B1); PG8_BAR;
            PG8_LDA(At, 1, 1); PG8_STAGE(PG8_SA(1, 0), a3, voffA);
            PG8_BAR; PG8_WAIT_L(0); PG8_MMA(1, 0, At, B0); PG8_BAR; PG8_SCHED;
            PG8_STAGE(PG8_SB(1, 1), b3 + hstep, voffB);
            PG8_WAIT_V(6); PG8_BAR; PG8_MMA(1, 1, At, B1); PG8_BAR;
            }
        }
        if constexpr (ALIGN_EPI) { if (wr == 0) PG8_BAR; }
        if constexpr (!Epi::AFTER_DRAIN) { E(acc, cur, wr, wc, fr, fq); E.rotate(); S.done(cur); }
        if (!has_next) break;
#pragma unroll
        for (int a = 0; a < 2; ++a)
#pragma unroll
            for (int b = 0; b < 2; ++b)
#pragma unroll
                for (int m = 0; m < 4; ++m)
#pragma unroll
                    for (int n = 0; n < 2; ++n) acc[a][b][m][n] = (f32x4){0.f, 0.f, 0.f, 0.f};
        cur = nxt; cA = nA; cB = nB; ++ui;
        if constexpr (ALIGN_EPI) { if (wr == 1) PG8_BAR; }
    }
    PG8_WAIT_V(0);
    if constexpr (!ALIGN_EPI) { if (wr == 0) PG8_BAR; }
    PG8_BAR;
    if constexpr (Epi::AFTER_DRAIN) { E.fused(acc, cur, wr, wc, fr, fq, lds, wid, lane); S.done(cur); }
#undef PG8_SA
#undef PG8_SB
#undef PG8_STAGE
#undef PG8_LDA
#undef PG8_LDB
#undef PG8_MMA
#undef PG8_WAIT_V
#undef PG8_WAIT_L
#undef PG8_BAR
#undef PG8_SCHED
}
}
#ifndef PG8_SP2
#define PG8_SP2 true
#endif
#ifndef PG8_ALIGN
#define PG8_ALIGN true
#endif
#include <hip/hip_bf16.h>
#include <cmath>
namespace attn_body {
using bf16=__hip_bfloat16;
using bf16x8=__attribute__((ext_vector_type(8)))short;
using s16x4=__attribute__((ext_vector_type(4)))short;
using f32x16=__attribute__((ext_vector_type(16)))float;
using u32x4=__attribute__((ext_vector_type(4)))unsigned;
constexpr int BATCH=16,NHEAD=8,SEQ=2048,D=64,QP=1792,KP=1792,OP=1024;
constexpr int NW=8,QBLK=32,QB=QBLK*NW,KVBLK=64,NQB=SEQ/QB;
constexpr int ATTN_UNIT_ROWS=QB;
__device__ __forceinline__ int crow(int r,int hi){return (r&3)+8*(r>>2)+4*hi;}
#define SBAR() __builtin_amdgcn_sched_barrier(0)
__device__ __forceinline__ void cmask(f32x16&p0,f32x16&p1,int jb,int qrel,int hi){
  const float NEG=-INFINITY; int kb=64*jb+4*hi;
  #pragma unroll
  for(int r=0;r<16;++r){int kv=kb+(r&3)+8*(r>>2); if(kv>qrel)p0[r]=NEG; if(kv+32>qrel)p1[r]=NEG;}
}

constexpr int NSLOT=3, SLOTB=8192;
constexpr int LDS_K=0, LDS_V=NSLOT*SLOTB, LDS_WS=2*NSLOT*SLOTB, LDS_OST=LDS_WS+NW*64*4, LDS_BYTES=LDS_OST+NW*4096;
constexpr float C2=0.125f*1.4426950408889634f;
__device__ __forceinline__ void glds16(const void*gsrc,unsigned lds_dst){unsigned keep;
  asm volatile("s_mov_b32 %0, m0\n\ts_mov_b32 m0, %2\n\ts_nop 0\n\tglobal_load_lds_dwordx4 %1, off\n\ts_mov_b32 m0, %0":"=&s"(keep):"v"(gsrc),"s"(lds_dst):"memory");}
__device__ __forceinline__ float max3f(float a,float b,float c){float r;asm("v_max3_f32 %0, %1, %2, %3":"=v"(r):"v"(a),"v"(b),"v"(c));return r;}
__device__ __forceinline__ float max2f(float a,float b){float r;asm("v_max_f32_e32 %0, %1, %2":"=v"(r):"v"(a),"v"(b));return r;}
__device__ __forceinline__ float fadd_s(float a,float b){float r;asm("v_add_f32_e32 %0, %1, %2":"=v"(r):"v"(a),"v"(b));return r;}
__device__ __forceinline__ float fsub_s(float a,float b){float r;asm("v_sub_f32_e32 %0, %1, %2":"=v"(r):"v"(a),"v"(b));return r;}
typedef float f32x2_t __attribute__((ext_vector_type(2))); typedef __bf16 bf16x2_t __attribute__((ext_vector_type(2)));
__device__ __forceinline__ unsigned cvtpk_s(float lo,float hi){f32x2_t v={lo,hi};bf16x2_t b=__builtin_convertvector(v,bf16x2_t);return __builtin_bit_cast(unsigned,b);}
#define WAIT_BAR(N) asm volatile("s_waitcnt vmcnt(" #N ") lgkmcnt(0)\n\ts_barrier":::"memory")

__device__ __forceinline__ void qkt(f32x16&p0,f32x16&p1,const char*Kslot,const bf16x8*qr,const f32x16&negm,int r32,int hi){
  const char*kb=Kslot+hi*1024+r32*16;
  #pragma unroll
  for(int d0=0;d0<4;++d0){
    const bf16x8 b0=*reinterpret_cast<const bf16x8*>(kb+d0*2048);
    const bf16x8 b1=*reinterpret_cast<const bf16x8*>(kb+d0*2048+512);
    if(d0==0){p0=__builtin_amdgcn_mfma_f32_32x32x16_bf16(b0,qr[0],negm,0,0,0);p1=__builtin_amdgcn_mfma_f32_32x32x16_bf16(b1,qr[0],negm,0,0,0);}
    else{p0=__builtin_amdgcn_mfma_f32_32x32x16_bf16(b0,qr[d0],p0,0,0,0);p1=__builtin_amdgcn_mfma_f32_32x32x16_bf16(b1,qr[d0],p1,0,0,0);}}
}
typedef __attribute__((address_space(3))) const char* lds_cptr;
typedef short v4i16_t __attribute__((ext_vector_type(4)));
__device__ __forceinline__ void kload8(bf16x8*kf,lds_cptr kp){
  kf[0]=*(const __attribute__((address_space(3))) bf16x8*)(kp);      kf[1]=*(const __attribute__((address_space(3))) bf16x8*)(kp+512);
  kf[2]=*(const __attribute__((address_space(3))) bf16x8*)(kp+2048); kf[3]=*(const __attribute__((address_space(3))) bf16x8*)(kp+2560);
  kf[4]=*(const __attribute__((address_space(3))) bf16x8*)(kp+4096); kf[5]=*(const __attribute__((address_space(3))) bf16x8*)(kp+4608);
  kf[6]=*(const __attribute__((address_space(3))) bf16x8*)(kp+6144); kf[7]=*(const __attribute__((address_space(3))) bf16x8*)(kp+6656);
}
__device__ __forceinline__ void kload2(bf16x8*kf,lds_cptr kp,int j){ kf[2*j]=*(const __attribute__((address_space(3))) bf16x8*)(kp+j*2048); kf[2*j+1]=*(const __attribute__((address_space(3))) bf16x8*)(kp+j*2048+512); }
__device__ __forceinline__ s16x4 vtr(lds_cptr p){ return __builtin_bit_cast(s16x4,__builtin_amdgcn_ds_read_tr16_b64_v4i16((__attribute__((address_space(3))) v4i16_t*)p)); }
__device__ __forceinline__ float rowmax(const f32x16&p0,const f32x16&p1){
  float a=max3f(p0[0],p0[1],p1[0]),b=max3f(p0[2],p0[3],p1[1]);a=max3f(a,p1[2],p1[3]);
  #pragma unroll
  for(int r=4;r<16;r+=4){a=max3f(a,p0[r],p0[r+1]);b=max3f(b,p0[r+2],p0[r+3]);a=max3f(a,p1[r],p1[r+1]);b=max3f(b,p1[r+2],p1[r+3]);}
  const float m=max2f(a,b);
  auto rr=__builtin_amdgcn_permlane32_swap(__float_as_uint(m),__float_as_uint(m),false,false);
  return max2f(__uint_as_float(rr[0]),__uint_as_float(rr[1]));
}
__device__ __forceinline__ void pv(f32x16*o,int vb,bf16x8 pa0,bf16x8 pa1,bf16x8 pa2,bf16x8 pa3){
  #pragma unroll
  for(int d0=0;d0<2;++d0){s16x4 lo[4],hi[4];
    #pragma unroll
    for(int ks=0;ks<4;++ks){
      asm volatile("ds_read_b64_tr_b16 %0,%1 offset:%c2":"=&v"(lo[ks]):"v"(vb),"i"(d0*4096+ks*1024):"memory");
      asm volatile("ds_read_b64_tr_b16 %0,%1 offset:%c2":"=&v"(hi[ks]):"v"(vb),"i"(d0*4096+ks*1024+512):"memory");}
    asm volatile("s_waitcnt lgkmcnt(0)":::"memory");SBAR();
    #define PK(k) (bf16x8){lo[k][0],lo[k][1],lo[k][2],lo[k][3],hi[k][0],hi[k][1],hi[k][2],hi[k][3]}
    o[d0]=__builtin_amdgcn_mfma_f32_32x32x16_bf16(pa0,PK(0),o[d0],0,0,0);
    o[d0]=__builtin_amdgcn_mfma_f32_32x32x16_bf16(pa1,PK(1),o[d0],0,0,0);
    o[d0]=__builtin_amdgcn_mfma_f32_32x32x16_bf16(pa2,PK(2),o[d0],0,0,0);
    o[d0]=__builtin_amdgcn_mfma_f32_32x32x16_bf16(pa3,PK(3),o[d0],0,0,0);
    #undef PK
  }
}

#ifndef ATTN_STORE16
#define ATTN_STORE16(p,v) (*(u32x4*)(p)=(v))
#endif
template<int THRL,bool NOMAX> __device__ __forceinline__ void attn_unit(int b,int h,int qb,const bf16*Q,const bf16*__restrict__ K,const bf16*__restrict__ V,bf16*O,char*shm,const float*qn,const __attribute__((address_space(3))) float*tab,float*ssqa){
  const int tid=threadIdx.x,lane=tid&63,r32=lane&31,hi=lane>>5; const int wid=__builtin_amdgcn_readfirstlane(tid>>6);
  const long rowbase=(long)b*SEQ; const int q0=qb*QB;
  const bf16*Qw=Q+(rowbase+q0+wid*QBLK)*QP+h*D;
  const int kvh=h>>2; const bf16*Kh=K+rowbase*KP+kvh*D,*Vh=V+rowbase*KP+kvh*D;
  const unsigned lds0=(unsigned)(uintptr_t)shm;
  float*wsf=(float*)(shm+LDS_WS)+wid*64;
  const bf16*ksrc=Kh+(long)lane*KP+wid*8;
  const bf16*vsrc=Vh+(long)(16*(wid&3)+(lane>>2))*KP+(wid>>2)*32+(lane&3)*8;
  const unsigned kdst=lds0+LDS_K+wid*1024, vdst=lds0+LDS_V+wid*1024;
  #define DMA_K(t,slot) glds16(ksrc+(long)(t)*KVBLK*KP,(unsigned)__builtin_amdgcn_readfirstlane(kdst+(slot)))
  #define DMA_V(t,slot) glds16(vsrc+(long)(t)*KVBLK*KP,(unsigned)__builtin_amdgcn_readfirstlane(vdst+(slot)))
  const int vb0=(int)(lds0+LDS_V)+((lane>>4)&1)*32+(lane&3)*8+(4*hi+((lane&15)>>2))*64;
  const char*Kbase=shm+LDS_K; bf16x8 kf[8];
  const lds_cptr shm3=(lds_cptr)shm; const lds_cptr kp0=shm3+LDS_K+hi*1024+r32*16; const lds_cptr vp0=shm3+LDS_V+((lane>>4)&1)*32+(lane&3)*8+(4*hi+((lane&15)>>2))*64;
  const int NT=SEQ/KVBLK;
  DMA_K(0,0);DMA_V(0,0);DMA_K(1,SLOTB);
  bf16x8 qr[4];
  #pragma unroll
  for(int d0=0;d0<4;++d0)qr[d0]=*reinterpret_cast<const bf16x8*>(&Qw[(long)r32*QP+d0*16+hi*8]);
  { typedef float f32x4_t __attribute__((ext_vector_type(4))); typedef __attribute__((address_space(3))) const f32x4_t* ltab4;
    float f[4][8]; float ss=0.f;
    #pragma unroll
    for(int d0=0;d0<4;++d0){
      #pragma unroll
      for(int j=0;j<8;++j){ f[d0][j]=__uint_as_float(((unsigned)(unsigned short)qr[d0][j])<<16); ss+=f[d0][j]*f[d0][j]; } }
    ss+=__shfl_xor(ss,32);
    const float rstd=1.0f/sqrtf(ss*(1.0f/64.0f)+1e-6f);
    const int tq_=q0+wid*QBLK+r32, prow=tq_>>6, pcol=tq_&63;
    float cr[8],sr[8],cc[8],sc[8];
    #pragma unroll
    for(int hf=0;hf<2;++hf){ const f32x4_t a=*(ltab4)(tab+prow*16+8*hi+4*hf), b2=*(ltab4)(tab+1024+prow*16+8*hi+4*hf), c=*(ltab4)(tab+pcol*16+8*hi+4*hf), d=*(ltab4)(tab+1024+pcol*16+8*hi+4*hf);
      #pragma unroll
      for(int e=0;e<4;++e){ cr[4*hf+e]=a[e]; sr[4*hf+e]=b2[e]; cc[4*hf+e]=c[e]; sc[4*hf+e]=d[e]; } }
    float g0[8],g1[8],g2[8],g3[8];
    #pragma unroll
    for(int hf=0;hf<2;++hf){ const f32x4_t a=*(ltab4)(tab+2048+8*hi+4*hf), b2=*(ltab4)(tab+2048+16+8*hi+4*hf), c=*(ltab4)(tab+2048+32+8*hi+4*hf), d=*(ltab4)(tab+2048+48+8*hi+4*hf);
      #pragma unroll
      for(int e=0;e<4;++e){ g0[4*hf+e]=a[e]; g1[4*hf+e]=b2[e]; g2[4*hf+e]=c[e]; g3[4*hf+e]=d[e]; } }
    u32x4 pk[4];
    #pragma unroll
    for(int jj=0;jj<4;++jj){ float o0[2],o1[2],o2[2],o3[2];
      #pragma unroll
      for(int e=0;e<2;++e){ const int j=2*jj+e; const float sc2=rstd*C2;
        const float n0=f[0][j]*sc2*g0[j], n1=f[1][j]*sc2*g1[j], n2=f[2][j]*sc2*g2[j], n3=f[3][j]*sc2*g3[j];
        o0[e]=n0*cr[j]-n1*sr[j]; o1[e]=n1*cr[j]+n0*sr[j]; o2[e]=n2*cc[j]-n3*sc[j]; o3[e]=n3*cc[j]+n2*sc[j]; }
      pk[0][jj]=cvtpk_s(o0[0],o0[1]); pk[1][jj]=cvtpk_s(o1[0],o1[1]); pk[2][jj]=cvtpk_s(o2[0],o2[1]); pk[3][jj]=cvtpk_s(o3[0],o3[1]); }
    #pragma unroll
    for(int d0=0;d0<4;++d0)qr[d0]=__builtin_bit_cast(bf16x8,pk[d0]);
  }
  float mhat=0.f,l_reg=0.f;f32x16 o[2];o[0]=f32x16{};o[1]=f32x16{};f32x16 negm=f32x16{};asm volatile("":"+v"(negm));
  const int qrel=wid*QBLK+r32;
  #define CMASK(P0,P1,t) do{}while(0)
  bool resc=false;
  #define START(P0,P1) do{ resc=false; \
    if constexpr(!NOMAX){ const float rm=rowmax(P0,P1); const float dl=rm; mhat=fadd_s(mhat,dl); \
      _Pragma("unroll") for(int r=0;r<16;++r){P0[r]=fsub_s(P0[r],dl);P1[r]=fsub_s(P1[r],dl);} \
      _Pragma("unroll") for(int r=0;r<16;++r)negm[r]=-mhat; asm volatile("":"+v"(negm)); } \
    _Pragma("unroll") for(int r=0;r<16;++r)P0[r]=__builtin_amdgcn_exp2f(P0[r]); }while(0)
  #define RESC() do{ if(resc){ asm volatile("s_waitcnt lgkmcnt(0)":::"memory"); \
      _Pragma("unroll") for(int d_=0;d_<2;++d_) _Pragma("unroll") for(int r=0;r<16;++r)o[d_][r]*=wsf[crow(r,hi)]; } }while(0)
  f32x16 pA0,pA1,pB0,pB1;
  int sl_prev=0,sl_cur=0,sl_next=SLOTB;
  #define ROT() do{sl_prev=sl_cur;sl_cur=sl_next;sl_next=(sl_next==(NSLOT-1)*SLOTB)?0:sl_next+SLOTB;}while(0)
  DMA_K(2,2*SLOTB);
  WAIT_BAR(3);
  qkt(pA0,pA1,Kbase,qr,negm,r32,hi);asm volatile("s_nop 15\n\ts_nop 7":"+v"(pA0),"+v"(pA1));CMASK(pA0,pA1,0);
  START(pA0,pA1);
  _Pragma("unroll") for(int r=0;r<16;++r)pA1[r]=__builtin_amdgcn_exp2f(pA1[r]);
  WAIT_BAR(0);
  DMA_K(3,0);DMA_V(1,SLOTB);
  ROT();
  kload8(kf,kp0+sl_cur);
  WAIT_BAR(2);
  s16x4 vlo[8],vhi[8]; u32x4 pw0,pw1,pw2,pw3;
  #define PKW(P,B) cvtpk_s(P[B],P[B+1])
  #define PAF(k) __builtin_bit_cast(bf16x8,pw##k)
  #define VFR(i) (bf16x8){vlo[i][0],vlo[i][1],vlo[i][2],vlo[i][3],vhi[i][0],vhi[i][1],vhi[i][2],vhi[i][3]}
  #define PIN(x) asm volatile("":"+v"(x))
  #define MX3(a,b,c) __builtin_fmaxf(__builtin_fmaxf((a),(b)),(c))
  #define GAPA(MF,A0,A1,A2,A3,W0,W1,PW) do{ MF; sacc+=A0; sacc+=A1; sacc+=A2; sacc+=A3; PIN(sacc); W0; W1; PIN(PW); SBAR(); }while(0)
  #define EX(v) __builtin_amdgcn_exp2f(v)
  #define GAPB(MF,X,B) do{ MF; X[B]=EX(X[B]); X[B+1]=EX(X[B+1]); X[B+2]=EX(X[B+2]); X[B+3]=EX(X[B+3]); PIN(X); SBAR(); }while(0)
  #define VRD(i) do{ vlo[i]=vtr(vp_+(((i)>>2)*4096+((i)&3)*1024)); vhi[i]=vtr(vp_+(((i)>>2)*4096+((i)&3)*1024+512)); }while(0)
  #define KRD(G,j) do{ if(G){ kload2(kf,kp0+sl_next,j); SBAR(); } }while(0)
  #define STEP(C0,C1,P0,P1,t,GK,GV,GL) do{ SBAR(); \
    const lds_cptr vp_=vp0+sl_prev; \
    VRD(0); SBAR(); float sacc=(P0[0]+P0[1]); \
    GAPA(C0=__builtin_amdgcn_mfma_f32_32x32x16_bf16(kf[0],qr[0],negm,0,0,0), P0[2],P0[3],P0[4],P0[5],     pw0[0]=PKW(P0,0), pw0[1]=PKW(P0,2), pw0); \
    VRD(4); SBAR(); GAPA(C1=__builtin_amdgcn_mfma_f32_32x32x16_bf16(kf[1],qr[0],negm,0,0,0), P0[6],P0[7],P0[8],P0[9],     pw0[2]=PKW(P0,4), pw0[3]=PKW(P0,6), pw0); \
    VRD(1); SBAR(); GAPA(C0=__builtin_amdgcn_mfma_f32_32x32x16_bf16(kf[2],qr[1],C0,0,0,0),   P0[10],P0[11],P0[12],P0[13], pw1[0]=PKW(P0,8), pw1[1]=PKW(P0,10), pw1); \
    VRD(5); SBAR(); GAPA(C1=__builtin_amdgcn_mfma_f32_32x32x16_bf16(kf[3],qr[1],C1,0,0,0),   P0[14],P0[15],P1[0],P1[1],   pw1[2]=PKW(P0,12),pw1[3]=PKW(P0,14), pw1); \
    VRD(2); SBAR(); GAPA(C0=__builtin_amdgcn_mfma_f32_32x32x16_bf16(kf[4],qr[2],C0,0,0,0),   P1[2],P1[3],P1[4],P1[5],     pw2[0]=PKW(P1,0), pw2[1]=PKW(P1,2), pw2); \
    VRD(6); SBAR(); GAPA(C1=__builtin_amdgcn_mfma_f32_32x32x16_bf16(kf[5],qr[2],C1,0,0,0),   P1[6],P1[7],P1[8],P1[9],     pw2[2]=PKW(P1,4), pw2[3]=PKW(P1,6), pw2); \
    VRD(3); SBAR(); GAPA(C0=__builtin_amdgcn_mfma_f32_32x32x16_bf16(kf[6],qr[3],C0,0,0,0),   P1[10],P1[11],P1[12],P1[13], pw3[0]=PKW(P1,8), pw3[1]=PKW(P1,10), pw3); \
    VRD(7); SBAR(); GAPA(C1=__builtin_amdgcn_mfma_f32_32x32x16_bf16(kf[7],qr[3],C1,0,0,0),   P1[14],P1[15],0.f,0.f,       pw3[2]=PKW(P1,12),pw3[3]=PKW(P1,14), pw3); \
    l_reg+=sacc; \
    if(GK){DMA_K((t)+3,sl_cur);} if(GV){DMA_V((t)+1,sl_next);} \
    CMASK(C0,C1,t); \
    if constexpr(NOMAX){ resc=false; } else { float a=MX3(C0[0],C0[1],C1[0]),b=MX3(C0[2],C0[3],C1[1]); a=MX3(a,C1[2],C1[3]); \
      _Pragma("unroll") for(int r=4;r<16;r+=4){a=MX3(a,C0[r],C0[r+1]);b=MX3(b,C0[r+2],C0[r+3]);a=MX3(a,C1[r],C1[r+1]);b=MX3(b,C1[r+2],C1[r+3]);} \
      float rm=__builtin_fmaxf(a,b); { auto rr=__builtin_amdgcn_permlane32_swap(__float_as_uint(rm),__float_as_uint(rm),false,false); rm=__builtin_fmaxf(__uint_as_float(rr[0]),__uint_as_float(rr[1])); } \
      resc=false; \
      if(__builtin_expect(__any(rm>(float)THRL),0)){ const float dl=__builtin_fmaxf(rm,0.f); mhat+=dl; \
        _Pragma("unroll") for(int r=0;r<16;++r){C0[r]-=dl;C1[r]-=dl;} \
        _Pragma("unroll") for(int r=0;r<16;++r)negm[r]=-mhat; asm volatile("":"+v"(negm)); \
        const float f=__builtin_amdgcn_exp2f(-dl); l_reg*=f; if(hi==0)wsf[r32]=f; resc=true; } } \
    SBAR(); \
    GAPB(o[0]=__builtin_amdgcn_mfma_f32_32x32x16_bf16(PAF(0),VFR(0),o[0],0,0,0), C0,0); \
    GAPB(o[1]=__builtin_amdgcn_mfma_f32_32x32x16_bf16(PAF(0),VFR(4),o[1],0,0,0), C0,4); \
    KRD(GL,0); GAPB(o[0]=__builtin_amdgcn_mfma_f32_32x32x16_bf16(PAF(1),VFR(1),o[0],0,0,0), C0,8); \
    KRD(GL,1); GAPB(o[1]=__builtin_amdgcn_mfma_f32_32x32x16_bf16(PAF(1),VFR(5),o[1],0,0,0), C0,12); \
    KRD(GL,2); GAPB(o[0]=__builtin_amdgcn_mfma_f32_32x32x16_bf16(PAF(2),VFR(2),o[0],0,0,0), C1,0); \
    KRD(GL,3); GAPB(o[1]=__builtin_amdgcn_mfma_f32_32x32x16_bf16(PAF(2),VFR(6),o[1],0,0,0), C1,4); \
    GAPB(o[0]=__builtin_amdgcn_mfma_f32_32x32x16_bf16(PAF(3),VFR(3),o[0],0,0,0), C1,8); \
    GAPB(o[1]=__builtin_amdgcn_mfma_f32_32x32x16_bf16(PAF(3),VFR(7),o[1],0,0,0), C1,12); \
    }while(0)
  int t=1;
  #undef CMASK
  #define CMASK(P0,P1,t) do{}while(0)
  for(;t+5<NT;t+=2){
    STEP(pB0,pB1,pA0,pA1,t,true,true,true);     WAIT_BAR(2); RESC(); ROT();
    STEP(pA0,pA1,pB0,pB1,t+1,true,true,true);   WAIT_BAR(2); RESC(); ROT();
  }
  #undef CMASK
  #define CMASK(P0,P1,t) do{}while(0)
  #define ENDW(tt) do{ if((tt)+3<NT){WAIT_BAR(2);} else if((tt)+2<NT){WAIT_BAR(1);} else {WAIT_BAR(0);} }while(0)
  for(;t+1<NT;t+=2){
    STEP(pB0,pB1,pA0,pA1,t,(t+3<NT),(t+1<NT),(t+1<NT));       ENDW(t);   RESC(); ROT();
    STEP(pA0,pA1,pB0,pB1,t+1,(t+4<NT),(t+2<NT),(t+2<NT));     ENDW(t+1); RESC(); ROT();
  }
  STEP(pB0,pB1,pA0,pA1,NT-1,false,false,false); RESC();
  { float sacc=pB0[0]+pB0[1]; _Pragma("unroll") for(int r=2;r<16;++r)sacc+=pB0[r]; _Pragma("unroll") for(int r=0;r<16;++r)sacc+=pB1[r]; l_reg+=sacc;
    pw0=(u32x4){PKW(pB0,0),PKW(pB0,2),PKW(pB0,4),PKW(pB0,6)};pw1=(u32x4){PKW(pB0,8),PKW(pB0,10),PKW(pB0,12),PKW(pB0,14)};pw2=(u32x4){PKW(pB1,0),PKW(pB1,2),PKW(pB1,4),PKW(pB1,6)};pw3=(u32x4){PKW(pB1,8),PKW(pB1,10),PKW(pB1,12),PKW(pB1,14)};
    SBAR(); pv(o,vb0+sl_cur,PAF(0),PAF(1),PAF(2),PAF(3)); }
  #undef PKW
  #undef PAF
  #undef VFR
  #undef PIN
  #undef MX3
  #undef GAPA
  #undef GAPB
  #undef EX
  #undef VRD
  #undef KRD
  #undef STEP
  #undef ENDW
  {auto rr=__builtin_amdgcn_permlane32_swap(__float_as_uint(l_reg),__float_as_uint(l_reg),false,false);l_reg=__uint_as_float(rr[0])+__uint_as_float(rr[1]);}
  if(hi==0)wsf[32+r32]=l_reg;asm volatile("s_waitcnt lgkmcnt(0)":::"memory");
  float rli[16];
  #pragma unroll
  for(int r=0;r<16;++r)rli[r]=__builtin_amdgcn_rcpf(wsf[32+crow(r,hi)]);
  bf16*Ow=O+(rowbase+q0+wid*QBLK)*OP+h*D;
  { bf16*stg=(bf16*)(shm+LDS_OST)+wid*2048;
    #pragma unroll
    for(int r=0;r<16;++r){const int orow=crow(r,hi);
      #pragma unroll
      for(int d0=0;d0<2;++d0)stg[orow*64+d0*32+r32]=__float2bfloat16(o[d0][r]*rli[r]);}
    asm volatile("s_waitcnt lgkmcnt(0)":::"memory");
    #pragma unroll
    for(int i=0;i<4;++i){const int row=i*8+(lane>>3),ch=lane&7; const u32x4 v=*(const u32x4*)(stg+row*64+ch*8); ATTN_STORE16(Ow+(long)row*OP+ch*8,v);
      float sq=0.f;
      #pragma unroll
      for(int k=0;k<4;++k){const float lo=__uint_as_float(v[k]<<16),hh=__uint_as_float(v[k]&0xffff0000u); sq+=lo*lo+hh*hh;}
      sq+=__shfl_xor(sq,1);sq+=__shfl_xor(sq,2);sq+=__shfl_xor(sq,4);
      if(ch==0)unsafeAtomicAdd(ssqa+rowbase+q0+wid*QBLK+row,sq);} }
  asm volatile("s_waitcnt lgkmcnt(0)\n\ts_barrier":::"memory");
  #undef DMA_K
  #undef DMA_V
  #undef CMASK
  #undef START
  #undef RESC
  #undef ROT
}
constexpr int ATTN_LDS_BYTES=LDS_BYTES;
struct AttnTensors { const bf16* Q; const bf16* K; const bf16* V; bf16* O; const float* qn; const __attribute__((address_space(3))) float* tab; float* ssqa; };
template<int THRL=8> __device__ __forceinline__ void attn_phase(char*lds,const AttnTensors&T,int grid,int block,bool nomax){
  const int vcu=(grid%8==0)?(block%8)*(grid/8)+block/8:block;
  constexpr int NU=BATCH*NHEAD*NQB;
  const int per=(NU+grid-1)/grid;
  for(int i=0;i<per;++i){ const int u=vcu*per+i; if(u>=NU)break; const int g=u>>5, hl=(u>>3)&3, qb=u&7; const int b=g>>1, kv=g&1;
    if(nomax)attn_unit<THRL,true>(b,kv*4+hl,qb,T.Q,T.K,T.V,T.O,lds,T.qn,T.tab,T.ssqa); else attn_unit<THRL,false>(b,kv*4+hl,qb,T.Q,T.K,T.V,T.O,lds,T.qn,T.tab,T.ssqa); }
}
#undef SBAR
#undef WAIT_BAR
}
#ifndef PROBE_DUP
#define PROBE_DUP -1
#endif
#ifndef PROBE_MASK
#define PROBE_MASK ((PROBE_DUP >= 0) ? (1 << PROBE_DUP) : 0)
#endif
#define REP(k) for (int rep_ = 0; rep_ < (((PROBE_MASK >> (k)) & 1) ? 2 : 1); ++rep_)
#ifndef MK_LAUNCHES
#define MK_LAUNCHES 1
#endif
constexpr int NWAVES = 8;
constexpr int BATCH = 16, SEQ = 2048, DMODEL = 1024, M = BATCH * SEQ;
constexpr int D_IN = 1792, D_FF = 2816, NGU = 2 * D_FF;
constexpr int COL_K = 512, COL_V = 640, COL_XL = 768, COL_GL = 1280;
constexpr float EPS = 1e-6f;
constexpr float L2E = 1.4426950408889634f;
constexpr int NPHASE = 8;
constexpr size_t MiB = 1u << 20;
constexpr size_t WS_CTL = 0, CTL_ZERO_BYTES = 16384;
constexpr size_t WS_SSQ = 65536;
constexpr size_t WS_SSQA = 65536 + 131072;
constexpr size_t WS_WIN = 1 * MiB, WS_WOUT = 5 * MiB, WS_WGU = 7 * MiB, WS_WD = 18 * MiB;
constexpr size_t WS_XN = 32 * MiB;
constexpr size_t WS_PROJ = 96 * MiB;
constexpr size_t WS_ATT = 208 * MiB;
constexpr size_t WS_YF = 240 * MiB, WS_YB = 272 * MiB;
constexpr size_t WS_FF = 32 * MiB;
constexpr size_t WS_H1B = 208 * MiB;
constexpr size_t WS_END = 304 * MiB;
constexpr int MISC_OFF = 131072, ROPE_TAB_OFF = 131072 + 1024;
constexpr int LDS_BYTES = 147456;
#define LAS __attribute__((address_space(3)))
typedef unsigned short bf16;
typedef unsigned v4u __attribute__((ext_vector_type(4)));
typedef unsigned v2u __attribute__((ext_vector_type(2)));
typedef float f32x4 __attribute__((ext_vector_type(4)));
typedef float f32x16 __attribute__((ext_vector_type(16)));
typedef float f32x2v __attribute__((ext_vector_type(2)));
typedef short bf16x8 __attribute__((ext_vector_type(8)));
#define LDS_WAIT() asm volatile("s_waitcnt lgkmcnt(0)" ::: "memory")
__device__ __forceinline__ unsigned f2bf(float f) { unsigned u = __builtin_bit_cast(unsigned, f); return (u + 0x7fffu + ((u >> 16) & 1u)) >> 16; }
typedef __bf16 bf16x2n_t __attribute__((ext_vector_type(2))); typedef float f32x2n_t __attribute__((ext_vector_type(2)));
__device__ __forceinline__ unsigned pk2(float lo, float hi) { const f32x2n_t v = {lo, hi}; return __builtin_bit_cast(unsigned, __builtin_convertvector(v, bf16x2n_t)); }
__device__ __forceinline__ float bflo(unsigned u) { return __builtin_bit_cast(float, u << 16); }
__device__ __forceinline__ float bfhi(unsigned u) { return __builtin_bit_cast(float, u & 0xffff0000u); }
__device__ __forceinline__ float wave_sum(float v) {
#pragma unroll
    for (int o = 1; o < 64; o <<= 1) v += __shfl_xor(v, o);
    return v;
}
__device__ __forceinline__ float sigmoidf_fast(float x) { return __builtin_amdgcn_rcpf(1.0f + __builtin_amdgcn_exp2f(-L2E * x)); }
__device__ __forceinline__ float gelu_tanh(float x) { const float z = 0.7978845608028654f * (x + 0.044715f * x * x * x); return x * sigmoidf_fast(2.0f * z); }

#define RLX_AGENT __ATOMIC_RELAXED, __HIP_MEMORY_SCOPE_AGENT
#define XB_TMO      128
#define XB_XCNT(j)  (256  + 64 * (j))
#define XB_XSUB(j)  (1280 + 64 * (j))
#define XB_XGEN(j)  (2304 + 64 * (j))
#define XB_TOP      3328
#define XB_TOPGEN   3392
#define XCD_BAR_WORDS 3456
#define XB_SPIN_CAP (1u << 18)

__device__ __forceinline__ unsigned xb_ld(unsigned* p)              { return __hip_atomic_load(p, __ATOMIC_RELAXED, __HIP_MEMORY_SCOPE_AGENT); }
__device__ __forceinline__ unsigned xb_add(unsigned* p, unsigned v) { return __hip_atomic_fetch_add(p, v, __ATOMIC_RELAXED, __HIP_MEMORY_SCOPE_AGENT); }
__device__ __forceinline__ unsigned xb_xcc_id() { return (unsigned)__builtin_amdgcn_s_getreg((3 << 11) | 20) & 0xFu; }
#define XB_SPIN(cond, bar) do { unsigned _sp = 0; while (cond) { __builtin_amdgcn_s_sleep(1); \
    if ((++_sp & 255u) == 0u) { if (xb_ld(&(bar)[XB_TMO])) break; if (_sp > XB_SPIN_CAP) { atomicAdd(&(bar)[XB_TMO], 1u); break; } } } } while (0)

struct XcdBarrier {
    unsigned* bar; unsigned x;
    volatile LAS unsigned* st;
};

__device__ __forceinline__ XcdBarrier xcd_barrier_post(unsigned* bar, volatile LAS unsigned* st) {
    XcdBarrier b; b.bar = bar; b.x = xb_xcc_id(); b.st = st;
    if (threadIdx.x == 0) (void)xb_add(&bar[XB_XCNT(b.x)], 1u);
    return b;
}
__device__ __forceinline__ void xcd_barrier_complete(unsigned* bar, unsigned x, unsigned& nloc, unsigned& nx) {
    const unsigned G = gridDim.x * gridDim.y * gridDim.z;
    unsigned sum, cnt, mine, sp = 0u;
    for (;;) {
        sum = 0u; cnt = 0u; mine = 0u;
#pragma unroll
        for (unsigned j = 0; j < 16; ++j) { const unsigned c = xb_ld(&bar[XB_XCNT(j)]); sum += c; cnt += (c > 0u) ? 1u : 0u; mine = (j == x) ? c : mine; }
        if (sum == G) break;
        __builtin_amdgcn_s_sleep(1);
        if ((++sp & 255u) == 0u) { if (xb_ld(&bar[XB_TMO])) break; if (sp > XB_SPIN_CAP) { atomicAdd(&bar[XB_TMO], 1u); break; } }
    }
    nloc = mine > 0u ? mine : 1u; nx = cnt > 0u ? cnt : 1u;
}

__device__ __forceinline__ void xcd_barrier(const XcdBarrier& b) {
    asm volatile("s_waitcnt vmcnt(0)" ::: "memory");
    __syncthreads();
    if (threadIdx.x == 0) {
        unsigned* bar = b.bar;
        __builtin_amdgcn_s_waitcnt(0);
        unsigned nloc = b.st[0], nx = b.st[1];
        if (nloc == 0u) { xcd_barrier_complete(bar, b.x, nloc, nx); b.st[0] = nloc; b.st[1] = nx; }
        const unsigned old = xb_add(&bar[XB_XSUB(b.x)], 1u);
        const unsigned gen = old / nloc;
        if (old + 1u == (gen + 1u) * nloc) {
            __builtin_amdgcn_fence(__ATOMIC_RELEASE, "agent");
            asm volatile("s_waitcnt vmcnt(0)" ::: "memory");
            const unsigned og = xb_add(&bar[XB_TOP], 1u);
            const unsigned tg = og / nx;
            if (og + 1u == (tg + 1u) * nx) xb_add(&bar[XB_TOPGEN], 1u);
            else XB_SPIN(xb_ld(&bar[XB_TOPGEN]) == tg, bar);
            __builtin_amdgcn_fence(__ATOMIC_ACQUIRE, "agent");
            xb_add(&bar[XB_XGEN(b.x)], 1u);
            asm volatile("s_waitcnt vmcnt(0)" ::: "memory");
        } else {
            XB_SPIN(xb_ld(&bar[XB_XGEN(b.x)]) == gen, bar);
            __builtin_amdgcn_fence(__ATOMIC_ACQUIRE, "agent");
            asm volatile("s_waitcnt vmcnt(0)" ::: "memory");
        }
    }
    __syncthreads();
}

__device__ __forceinline__ void p0_transpose_item(const float* W, int K, int N, bf16* WT, int k0, int n0, int drow0, const float* kscale, LAS float* scr, int lane) {
    { const int r8 = lane >> 3, c4 = (lane & 7) * 4; f32x4 v[8];
#pragma unroll
      for (int i = 0; i < 8; ++i) v[i] = __builtin_nontemporal_load((const f32x4*)(W + (size_t)(k0 + 8 * i + r8) * N + n0 + c4));
#pragma unroll
      for (int i = 0; i < 8; ++i) { const int kk = 8 * i + r8; f32x4 w = v[i]; if (kscale) w = w * kscale[k0 + kk]; LAS float* d = scr + kk * 33 + c4; d[0] = w.x; d[1] = w.y; d[2] = w.z; d[3] = w.w; } }
    LDS_WAIT(); asm volatile("" ::: "memory");
    const int c = lane & 7;
#pragma unroll
    for (int j = 0; j < 4; ++j) { const int n = (lane >> 3) + 8 * j; const LAS float* s = scr + (8 * c) * 33 + n;
        v4u o; o.x = pk2(s[0 * 33], s[1 * 33]); o.y = pk2(s[2 * 33], s[3 * 33]); o.z = pk2(s[4 * 33], s[5 * 33]); o.w = pk2(s[6 * 33], s[7 * 33]);
        *(v4u*)(WT + (size_t)(drow0 + n) * K + k0 + 8 * c) = o; }
    LDS_WAIT(); asm volatile("" ::: "memory");
}
struct Ptrs {
    const float *x, *norm_mix, *w_in, *q_norm, *k_norm, *conv_w, *conv_b, *w_rgate, *b_rgate, *w_igate, *b_igate, *lam, *on_attn, *on_lru, *w_out, *norm_ffn, *w_gate, *w_up, *w_down;
    float* out; float* ssq; float* ssqa; bf16 *Win_t, *Wout_t, *Wgu_t, *Wd_t, *XN, *PROJ, *ATT, *YF, *YB, *FF;
};
constexpr int P0_I_IN = 16 * 56, P0_NITEMS = 16 * 56 + 16 * 32 + 2 * 16 * 88 + 44 * 32;
__device__ __forceinline__ void p0_transposes(const Ptrs& F, LAS unsigned char* lds, int gw, int NGW, int wave, int lane, int it0, int it1) {
    LAS float* scr = (LAS float*)(lds + wave * 16384);
    constexpr int I_IN = 16 * 56, I_OUT = 16 * 32, I_G = 16 * 88, I_D = 44 * 32, NITEMS = I_IN + I_OUT + 2 * I_G + I_D;
    for (int it = gw + it0; it < it1; it += NGW) {
        int r = it;
        if (r < I_IN) { const int kb = r / 56, nb = r % 56; p0_transpose_item(F.w_in, 1024, 1792, F.Win_t, 64 * kb, 32 * nb, 32 * nb, nullptr, scr, lane); continue; } r -= I_IN;
        if (r < I_OUT) { const int kb = r / 32, nb = r % 32; p0_transpose_item(F.w_out, 1024, 1024, F.Wout_t, 64 * kb, 32 * nb, 32 * nb, kb < 8 ? F.on_attn : nullptr, scr, lane); continue; } r -= I_OUT;
        if (r < I_G) { const int kb = r / 88, nb = r % 88, n0 = 32 * nb; p0_transpose_item(F.w_gate, 1024, 2816, F.Wgu_t, 64 * kb, n0, 256 * (n0 >> 7) + (n0 & 127), F.norm_ffn, scr, lane); continue; } r -= I_G;
        if (r < I_G) { const int kb = r / 88, nb = r % 88, n0 = 32 * nb; p0_transpose_item(F.w_up, 1024, 2816, F.Wgu_t, 64 * kb, n0, 256 * (n0 >> 7) + (n0 & 127) + 128, F.norm_ffn, scr, lane); continue; } r -= I_G;
        { const int kb = r / 32, nb = r % 32; p0_transpose_item(F.w_down, 2816, 1024, F.Wd_t, 64 * kb, 32 * nb, 32 * nb, nullptr, scr, lane); }
    }
}
__device__ __forceinline__ void p0_xn(const Ptrs& F, int gw, int NGW, int lane) {
    f32x4 g[4];
#pragma unroll
    for (int j = 0; j < 4; ++j) g[j] = ((const f32x4*)F.norm_mix)[lane + 64 * j];
    f32x4 nx[4], ny[4];
    if (gw < M) { const f32x4* xr = (const f32x4*)(F.x + (size_t)gw * DMODEL) + lane;
#pragma unroll
        for (int j = 0; j < 4; ++j) nx[j] = __builtin_nontemporal_load(xr + 64 * j); }
    if (gw + NGW < M) { const f32x4* xr = (const f32x4*)(F.x + (size_t)(gw + NGW) * DMODEL) + lane;
#pragma unroll
        for (int j = 0; j < 4; ++j) ny[j] = __builtin_nontemporal_load(xr + 64 * j); }
    for (int m = gw; m < M; m += NGW) {
        f32x4 v[4]; float s = 0.f;
#pragma unroll
        for (int j = 0; j < 4; ++j) { v[j] = nx[j]; nx[j] = ny[j]; }
        if (m + 2 * NGW < M) { const f32x4* xr = (const f32x4*)(F.x + (size_t)(m + 2 * NGW) * DMODEL) + lane;
#pragma unroll
            for (int j = 0; j < 4; ++j) ny[j] = __builtin_nontemporal_load(xr + 64 * j); }
#pragma unroll
        for (int j = 0; j < 4; ++j) s += (v[j].x * v[j].x + v[j].y * v[j].y) + (v[j].z * v[j].z + v[j].w * v[j].w);
        const float rstd = 1.0f / sqrtf(wave_sum(s) * (1.0f / DMODEL) + EPS);
        v2u* o8 = (v2u*)(F.XN + (size_t)m * DMODEL) + lane;
#pragma unroll
        for (int j = 0; j < 4; ++j) { v2u w; w.x = pk2(v[j].x * rstd * g[j].x, v[j].y * rstd * g[j].y); w.y = pk2(v[j].z * rstd * g[j].z, v[j].w * rstd * g[j].w); o8[64 * j] = w; }
    }
    for (int i = gw * 64 + lane; i < M; i += NGW * 64) { F.ssq[i] = 0.f; F.ssqa[i] = 0.f; }
}

constexpr int NKP = M * 2 / 16;
__device__ __forceinline__ void rope_table(LAS unsigned char* lds, int off, int tid) {
    LAS float* TC = (LAS float*)(lds + off); LAS float* TS = TC + 1024;
    for (int idx = tid; idx < 1024; idx += NWAVES * 64) { const int pos = idx >> 4, j = idx & 15; const float inv = exp2f(-(float)j * (13.287712379549449f / 16.0f));
        float rev = (float)pos * inv * 0.15915494309189535f; rev -= floorf(rev); TC[idx] = __builtin_amdgcn_cosf(rev); TS[idx] = __builtin_amdgcn_sinf(rev); }
    __syncthreads();
}
__device__ __forceinline__ void k_pass(const Ptrs& F, bf16* DST, LAS unsigned char* lds, int gw, int NGW, int tid, int lane) {
    const int sub = lane & 3, hl = lane >> 2;
    v2u pre0[4], pre1[4];
#pragma unroll
    for (int qd = 0; qd < 4; ++qd) { pre0[qd] = (v2u){0u, 0u}; pre1[qd] = (v2u){0u, 0u}; }
    if (gw < NKP) { const int hidx = gw * 16 + hl, m = hidx >> 1, hh = 8 + (hidx & 1); const bf16* p = F.PROJ + (size_t)m * D_IN + hh * 64 + 4 * sub;
#pragma unroll
        for (int qd = 0; qd < 4; ++qd) pre0[qd] = *(const v2u*)(p + 16 * qd); }
    if (gw + NGW < NKP) { const int hidx = (gw + NGW) * 16 + hl, m = hidx >> 1, hh = 8 + (hidx & 1); const bf16* p = F.PROJ + (size_t)m * D_IN + hh * 64 + 4 * sub;
#pragma unroll
        for (int qd = 0; qd < 4; ++qd) pre1[qd] = *(const v2u*)(p + 16 * qd); }
    rope_table(lds, 0, tid);
    const LAS float* TC = (const LAS float*)lds; const LAS float* TS = TC + 1024;
    int jstep = 0;
    for (int it = gw; it < NKP; it += NGW, ++jstep) {
        const int hidx = it * 16 + hl, m = hidx >> 1, hh = 8 + (hidx & 1);
        const bf16* p = F.PROJ + (size_t)m * D_IN + hh * 64 + 4 * sub;
        v2u raw[4]; float v[4][4]; float s = 0.f;
        if (jstep == 0) {
#pragma unroll
            for (int qd = 0; qd < 4; ++qd) raw[qd] = pre0[qd];
        } else if (jstep == 1) {
#pragma unroll
            for (int qd = 0; qd < 4; ++qd) raw[qd] = pre1[qd];
        } else {
#pragma unroll
            for (int qd = 0; qd < 4; ++qd) raw[qd] = *(const v2u*)(p + 16 * qd);
        }
#pragma unroll
        for (int qd = 0; qd < 4; ++qd) { v[qd][0] = bflo(raw[qd].x); v[qd][1] = bfhi(raw[qd].x); v[qd][2] = bflo(raw[qd].y); v[qd][3] = bfhi(raw[qd].y);
            s += (v[qd][0] * v[qd][0] + v[qd][1] * v[qd][1]) + (v[qd][2] * v[qd][2] + v[qd][3] * v[qd][3]); }
        s += __shfl_xor(s, 1); s += __shfl_xor(s, 2);
        const float rstd = 1.0f / sqrtf(s * (1.0f / 64.0f) + EPS);
#pragma unroll
        for (int qd = 0; qd < 4; ++qd) { const f32x4 gv = *(const f32x4*)(F.k_norm + 16 * qd + 4 * sub);
#pragma unroll
            for (int e = 0; e < 4; ++e) v[qd][e] = v[qd][e] * rstd * gv[e]; }
        const int t = m & (SEQ - 1), prow = t >> 6, pcol = t & 63;
        const f32x4 cr = *(const LAS f32x4*)(TC + prow * 16 + 4 * sub), sr = *(const LAS f32x4*)(TS + prow * 16 + 4 * sub);
        const f32x4 cc = *(const LAS f32x4*)(TC + pcol * 16 + 4 * sub), sc = *(const LAS f32x4*)(TS + pcol * 16 + 4 * sub);
        float o[4][4];
#pragma unroll
        for (int e = 0; e < 4; ++e) { o[0][e] = v[0][e] * cr[e] - v[1][e] * sr[e]; o[1][e] = v[1][e] * cr[e] + v[0][e] * sr[e];
            o[2][e] = v[2][e] * cc[e] - v[3][e] * sc[e]; o[3][e] = v[3][e] * cc[e] + v[2][e] * sc[e]; }
        bf16* q = DST + (size_t)m * D_IN + hh * 64 + 4 * sub;
#pragma unroll
        for (int qd = 0; qd < 4; ++qd) { v2u w; w.x = pk2(o[qd][0], o[qd][1]); w.y = pk2(o[qd][2], o[qd][3]); *(v2u*)(q + 16 * qd) = w; }
    }
    __syncthreads();
}

namespace lru {
constexpr int XA_OFF = 0, XA_PITCH = 144, XA_BYTES = 128 * 144, PY_OFF = 2 * XA_BYTES, PY_BYTES = 4 * 64 * 2 * 4, CW_OFF = PY_OFF + 2 * PY_BYTES, YS_OFF = CW_OFF + 1280, YS_BYTES = 128 * 128;
__device__ __forceinline__ int crow(int r, int hi) { return (r & 3) + 8 * (r >> 2) + 4 * hi; }
}
__device__ __forceinline__ void lru_item(const Ptrs& F, LAS unsigned char* lds, int b, int nb, int dir, int tid, int lane, int wave) {
    using namespace lru;
    const int hi = lane >> 5, n32 = lane & 31, tq = wave >> 1, chh = wave & 1;
    const int cl_ = 32 * chh + n32, C = dir * 512 + 64 * nb + cl_;
    bf16x8 Br[4], Bi[4];
    { const float* wr_p = F.w_rgate + (size_t)(dir * 8 + nb) * 4096 + cl_; const float* wi_p = F.w_igate + (size_t)(dir * 8 + nb) * 4096 + cl_;
#pragma unroll
      for (int ks = 0; ks < 4; ++ks)
#pragma unroll
          for (int j = 0; j < 8; ++j) { const int k = 16 * ks + 8 * hi + j; Br[ks][j] = (short)f2bf(wr_p[k * 64]); Bi[ks][j] = (short)f2bf(wi_p[k * 64]); } }
    const float brn = -L2E * F.b_rgate[C], bin = -L2E * F.b_igate[C];
    const float nl = -F.lam[C];
    const float sp = fmaxf(nl, 0.f) + log1pf(expf(-fabsf(nl)));
    const float cl2 = -8.0f * sp * L2E;
    const int p0 = tid >> 3, c8 = (tid & 7) * 8;
    LAS float* CW = (LAS float*)(lds + CW_OFF);
    if (tid < 320) CW[tid] = (tid < 256) ? F.conv_w[(tid >> 6) * 512 + 64 * nb + (tid & 63)] : F.conv_b[64 * nb + (tid & 63)];
    const bf16* xl = F.PROJ + (size_t)b * SEQ * D_IN + COL_XL + 64 * nb + c8;
    bf16* Yb = (dir ? F.YB : F.YF) + (size_t)b * SEQ * 512 + 64 * nb;
#define LRU_FLUSH(ck_) do { const LAS unsigned char* ys_ = lds + YS_OFF + ((ck_) & 1) * YS_BYTES; \
        _Pragma("unroll") for (int j_ = 0; j_ < 2; ++j_) { const int q_ = tid + 512 * j_, p_ = q_ >> 3, sg_ = q_ & 7; const v4u v_ = *(const LAS v4u*)(ys_ + p_ * 128 + sg_ * 16); \
            const int P_ = 128 * (ck_) + p_, t_ = dir ? (SEQ - 1 - P_) : P_; __builtin_nontemporal_store(v_, (v4u*)(Yb + (size_t)t_ * 512 + sg_ * 8)); } } while (0)
    float H = 0.f;
#define LRU_BAR() asm volatile("s_waitcnt lgkmcnt(0)\n\ts_barrier" ::: "memory")
#define LRU_LOAD(ck_) do { _Pragma("unroll") for (int half = 0; half < 2; ++half) { const int P_ = 128 * (ck_) + p0 + 64 * half, t_ = dir ? (SEQ - 1 - P_) : P_; \
        _Pragma("unroll") for (int tap = 0; tap < 4; ++tap) { const int tr = t_ - 1 + tap; raw[half][tap] = (tr >= 0 && tr < SEQ) ? *(const v4u*)(xl + (size_t)tr * D_IN) : (v4u){0u, 0u, 0u, 0u}; } } } while (0)
#define LRU_CONV(buf_) do { float cw[4][8], cb[8]; \
        _Pragma("unroll") for (int tap = 0; tap < 5; ++tap) { const f32x4 u0 = *(const LAS f32x4*)(CW + tap * 64 + c8), u1 = *(const LAS f32x4*)(CW + tap * 64 + c8 + 4); \
            float* d = (tap < 4) ? cw[tap < 4 ? tap : 0] : cb; d[0] = u0.x; d[1] = u0.y; d[2] = u0.z; d[3] = u0.w; d[4] = u1.x; d[5] = u1.y; d[6] = u1.z; d[7] = u1.w; } \
        _Pragma("unroll") for (int half = 0; half < 2; ++half) { const int pp = p0 + 64 * half; float a[8]; \
            _Pragma("unroll") for (int j = 0; j < 8; ++j) a[j] = cb[j]; \
            _Pragma("unroll") for (int tap = 0; tap < 4; ++tap) { const v4u rw = raw[half][tap]; \
                a[0] += cw[tap][0] * bflo(rw.x); a[1] += cw[tap][1] * bfhi(rw.x); a[2] += cw[tap][2] * bflo(rw.y); a[3] += cw[tap][3] * bfhi(rw.y); \
                a[4] += cw[tap][4] * bflo(rw.z); a[5] += cw[tap][5] * bfhi(rw.z); a[6] += cw[tap][6] * bflo(rw.w); a[7] += cw[tap][7] * bfhi(rw.w); } \
            v4u w; w.x = pk2(a[0], a[1]); w.y = pk2(a[2], a[3]); w.z = pk2(a[4], a[5]); w.w = pk2(a[6], a[7]); \
            *(LAS v4u*)(lds + XA_OFF + (buf_) * XA_BYTES + pp * XA_PITCH + c8 * 2) = w; } } while (0)
    v4u raw[2][4];
    LRU_LOAD(0);
    __syncthreads();
    LRU_CONV(0);
    LRU_LOAD(1);
    LRU_BAR();
    for (int ck = 0; ck < SEQ / 128; ++ck) {
        const LAS unsigned char* xa = lds + XA_OFF + (ck & 1) * XA_BYTES;
        LAS float* PY = (LAS float*)(lds + PY_OFF + (ck & 1) * PY_BYTES);
        f32x16 dr = {}, di = {};
#pragma unroll
        for (int ks = 0; ks < 4; ++ks) { const bf16x8 A = *(const LAS bf16x8*)(xa + (32 * tq + n32) * XA_PITCH + (16 * ks + 8 * hi) * 2);
            dr = __builtin_amdgcn_mfma_f32_32x32x16_bf16(A, Br[ks], dr, 0, 0, 0); di = __builtin_amdgcn_mfma_f32_32x32x16_bf16(A, Bi[ks], di, 0, 0, 0); }
        float pc[16], yl[16];
#pragma unroll
        for (int r = 0; r < 16; ++r) { const int p = 32 * tq + crow(r, hi); const float xcv = __builtin_bit_cast(float, (unsigned)(*(const LAS unsigned short*)(xa + p * XA_PITCH + cl_ * 2)) << 16);
            const float rg = __builtin_amdgcn_rcpf(1.0f + __builtin_amdgcn_exp2f(__builtin_fmaf(dr[r], -L2E, brn))), ig = __builtin_amdgcn_rcpf(1.0f + __builtin_amdgcn_exp2f(__builtin_fmaf(di[r], -L2E, bin)));
            const float a = __builtin_amdgcn_exp2f(rg * cl2); const float om = __builtin_fmaf(-a, a, 1.0f);
            const float x = __builtin_amdgcn_sqrtf(om) * ig * xcv;
            if ((r & 3) == 0) { pc[r] = a; yl[r] = x; } else { pc[r] = a * pc[r - 1]; yl[r] = __builtin_fmaf(a, yl[r - 1], x); } }
        float Pm[4], Ym[4], Po[4], Yo[4];
#pragma unroll
        for (int g = 0; g < 4; ++g) { Pm[g] = pc[4 * g + 3]; Ym[g] = yl[4 * g + 3]; Po[g] = __shfl_xor(Pm[g], 32); Yo[g] = __shfl_xor(Ym[g], 32); }
        float E = 0.f, Q = 1.f, Eo[4], Qo[4];
#pragma unroll
        for (int g = 0; g < 4; ++g) {
            const float P0 = hi ? Po[g] : Pm[g], Y0 = hi ? Yo[g] : Ym[g], P1 = hi ? Pm[g] : Po[g], Y1 = hi ? Ym[g] : Yo[g];
            const float E1 = __builtin_fmaf(P0, E, Y0), Q1 = Q * P0;
            Eo[g] = hi ? E1 : E; Qo[g] = hi ? Q1 : Q;
            E = __builtin_fmaf(P1, E1, Y1); Q = Q1 * P1; }
        if (hi == 0) *(LAS f32x2v*)(PY + (tq * 64 + cl_) * 2) = (f32x2v){Q, E};
        __builtin_amdgcn_sched_barrier(0);
        if (ck + 1 < SEQ / 128) { LRU_CONV((ck + 1) & 1); if (ck + 2 < SEQ / 128) LRU_LOAD(ck + 2); }
        LRU_BAR();
        if (ck > 0) LRU_FLUSH(ck - 1);
        float cw_ = H, hall = H;
#pragma unroll
        for (int q2 = 0; q2 < 4; ++q2) { const f32x2v t2 = *(const LAS f32x2v*)(PY + (q2 * 64 + cl_) * 2); if (q2 == tq) cw_ = hall; hall = __builtin_fmaf(t2.x, hall, t2.y); }
        H = hall;
#pragma unroll
        for (int g = 0; g < 4; ++g) { const float cg = __builtin_fmaf(Qo[g], cw_, Eo[g]);
#pragma unroll
            for (int e = 0; e < 4; ++e) { const int r = 4 * g + e; const float y = __builtin_fmaf(pc[r], cg, yl[r]);
                *(LAS unsigned short*)(lds + YS_OFF + (ck & 1) * YS_BYTES + (32 * tq + crow(r, hi)) * 128 + cl_ * 2) = (unsigned short)f2bf(y); } }
    }
    LRU_BAR();
    LRU_FLUSH(SEQ / 128 - 1);
    __syncthreads();
#undef LRU_CONV
#undef LRU_FLUSH
}

struct CombRow { v4u yf, yb, gg; float sa; };
__device__ __forceinline__ void comb_load(const Ptrs& F, int row, int lane, CombRow& r) {
    r.yf = __builtin_nontemporal_load((const v4u*)(F.YF + (size_t)row * 512 + lane * 8)); r.yb = __builtin_nontemporal_load((const v4u*)(F.YB + (size_t)row * 512 + lane * 8));
    r.gg = __builtin_nontemporal_load((const v4u*)(F.PROJ + (size_t)row * D_IN + COL_GL + lane * 8)); r.sa = F.ssqa[row];
}
__device__ __forceinline__ void combine_pass(const Ptrs& F, bf16* MIX, int gw, int NGW, int lane) {
    const f32x4 gl0 = *(const f32x4*)(F.on_lru + lane * 8), gl1 = *(const f32x4*)(F.on_lru + lane * 8 + 4);
    CombRow n0, n1;
    if (gw < M) comb_load(F, gw, lane, n0);
    if (gw + NGW < M) comb_load(F, gw + NGW, lane, n1);
    for (int row = gw; row < M; row += NGW) {
        const CombRow c = n0; n0 = n1;
        if (row + 2 * NGW < M) comb_load(F, row + 2 * NGW, lane, n1);
        const v4u yf = c.yf, yb = c.yb, gg = c.gg; const float sa = c.sa;
        const float f[8] = {bflo(yf.x), bfhi(yf.x), bflo(yf.y), bfhi(yf.y), bflo(yf.z), bfhi(yf.z), bflo(yf.w), bfhi(yf.w)};
        const float bb[8] = {bflo(yb.x), bfhi(yb.x), bflo(yb.y), bfhi(yb.y), bflo(yb.z), bfhi(yb.z), bflo(yb.w), bfhi(yb.w)};
        const float g8[8] = {bflo(gg.x), bfhi(gg.x), bflo(gg.y), bfhi(gg.y), bflo(gg.z), bfhi(gg.z), bflo(gg.w), bfhi(gg.w)};
        float v[8]; float s = 0.f;
#pragma unroll
        for (int j = 0; j < 8; ++j) { v[j] = (f[j] + bb[j]) * gelu_tanh(g8[j]); s += v[j] * v[j]; }
        const float sc = sqrtf(sa * (1.0f / 512.0f) + EPS) / sqrtf(wave_sum(s) * (1.0f / 512.0f) + EPS);
        v4u w; w.x = pk2(v[0] * sc * gl0[0], v[1] * sc * gl0[1]); w.y = pk2(v[2] * sc * gl0[2], v[3] * sc * gl0[3]);
        w.z = pk2(v[4] * sc * gl1[0], v[5] * sc * gl1[1]); w.w = pk2(v[6] * sc * gl1[2], v[7] * sc * gl1[3]);
        *(v4u*)(MIX + (size_t)row * 1024 + 512 + lane * 8) = w;
    }
}

struct Args { const float* in[19]; float* out; unsigned char* ws; int ph_lo, ph_hi; };
__global__ void __launch_bounds__(NWAVES * 64, 2) mk_fwd(Args args) {
    extern __shared__ __attribute__((aligned(16))) unsigned char lds[];
    LAS unsigned char* L = (LAS unsigned char*)lds;
    const int tid = threadIdx.x, lane = tid & 63, wave = __builtin_amdgcn_readfirstlane(tid >> 6);
    const int G = gridDim.x, bx = blockIdx.x;
    const int vcu = (G % 8 == 0) ? (bx % 8) * (G / 8) + bx / 8 : bx;
    const int gw = vcu * NWAVES + wave, NGW = G * NWAVES;
    unsigned char* ws = args.ws;
    Ptrs F;
    F.x = args.in[0]; F.norm_mix = args.in[1]; F.w_in = args.in[2]; F.q_norm = args.in[3]; F.k_norm = args.in[4]; F.conv_w = args.in[5]; F.conv_b = args.in[6];
    F.w_rgate = args.in[7]; F.b_rgate = args.in[8]; F.w_igate = args.in[9]; F.b_igate = args.in[10]; F.lam = args.in[11]; F.on_attn = args.in[12]; F.on_lru = args.in[13];
    F.w_out = args.in[14]; F.norm_ffn = args.in[15]; F.w_gate = args.in[16]; F.w_up = args.in[17]; F.w_down = args.in[18];
    F.out = args.out; F.ssq = (float*)(ws + WS_SSQ); F.ssqa = (float*)(ws + WS_SSQA);
    F.Win_t = (bf16*)(ws + WS_WIN); F.Wout_t = (bf16*)(ws + WS_WOUT); F.Wgu_t = (bf16*)(ws + WS_WGU); F.Wd_t = (bf16*)(ws + WS_WD);
    F.XN = (bf16*)(ws + WS_XN); F.PROJ = (bf16*)(ws + WS_PROJ); F.ATT = (bf16*)(ws + WS_ATT); F.YF = (bf16*)(ws + WS_YF); F.YB = (bf16*)(ws + WS_YB); F.FF = (bf16*)(ws + WS_FF);
    bf16* MIX = F.XN; bf16* H1B = (bf16*)(ws + WS_H1B);
    const int lo = args.ph_lo, hi = args.ph_hi;
    volatile LAS unsigned* MISC = (volatile LAS unsigned*)(L + MISC_OFF);
    if (tid < 64) MISC[tid] = 0u;
    __syncthreads();
    XcdBarrier bar; bar.bar = (unsigned*)(ws + WS_CTL); bar.x = 0; bar.st = MISC + 8;
    if (hi - lo > 1) bar = xcd_barrier_post((unsigned*)(ws + WS_CTL), MISC + 8);
    if (hi > 1000) cooperative_groups::this_grid().sync();
#define IN(k) (lo <= (k) && (k) < hi)
#define SEAM(k) do { if (IN(k) && IN((k) + 1)) { xcd_barrier(bar); if (PROBE_DUP == 9) xcd_barrier(bar); } } while (0)

    if (IN(0)) REP(0) { p0_transposes(F, L, gw, NGW, wave, lane, 0, (G == 256 && hi > 1) ? P0_I_IN : P0_NITEMS); p0_xn(F, gw, NGW, lane); __syncthreads(); }
    SEAM(0);
    if (IN(1)) REP(1) { pg8::Gemm g{F.XN, F.Win_t, M, D_IN, DMODEL}; pg8::StaticOrder S; S.init(M, D_IN, G, bx); pg8::EpiStoreBf16 E{F.PROJ, D_IN};
        pg8::gemm_phase<pg8::EpiStoreBf16, pg8::StaticOrder, PG8_ALIGN, PG8_SP2>(L, g, S, E);
        if (G == 256 && lo == 0 && bx >= 128) { __syncthreads(); p0_transposes(F, L, (bx - 128) * NWAVES + wave, 128 * NWAVES, wave, lane, P0_I_IN, P0_NITEMS); } }
    SEAM(1);
    if (IN(2)) { k_pass(F, F.PROJ, L, gw, NGW, tid, lane);
        REP(2) for (int item = vcu; item < BATCH * 16; item += G) lru_item(F, L, item >> 4, (item >> 1) & 7, item & 1, tid, lane, wave); }
    SEAM(2);
    if (IN(3)) REP(3) { const attn_body::AttnTensors AT{(const attn_body::bf16*)F.PROJ, (const attn_body::bf16*)(F.PROJ + COL_K), (const attn_body::bf16*)(F.PROJ + COL_V), (attn_body::bf16*)MIX, F.q_norm, (const LAS float*)(L + ROPE_TAB_OFF), F.ssqa};
        if (tid < 128) ((LAS float*)(L + ROPE_TAB_OFF))[2048 + tid] = (tid < 64) ? F.q_norm[tid] : F.k_norm[tid - 64];
        rope_table(L, ROPE_TAB_OFF, tid);
        float mq = 0.f, mk = 0.f;
        for (int i = 0; i < 16; ++i) { const f32x4 a = ((const LAS f32x4*)(L + ROPE_TAB_OFF + 8192))[i], b2 = ((const LAS f32x4*)(L + ROPE_TAB_OFF + 8192 + 256))[i];
            mq = fmaxf(fmaxf(mq, fmaxf(fabsf(a.x), fabsf(a.y))), fmaxf(fabsf(a.z), fabsf(a.w))); mk = fmaxf(fmaxf(mk, fmaxf(fabsf(b2.x), fabsf(b2.y))), fmaxf(fabsf(b2.z), fabsf(b2.w))); }
        const bool nomax = __builtin_amdgcn_readfirstlane((11.55f * 1.05f * mq * mk < 40.0f) ? 1 : 0) != 0;
        attn_body::attn_phase<8>((char*)lds, AT, G, bx, nomax); }
    SEAM(3);
    if (IN(4)) REP(4) combine_pass(F, MIX, gw, NGW, lane);
    SEAM(4);
    if (IN(5)) REP(5) { pg8::Gemm g{MIX, F.Wout_t, M, DMODEL, DMODEL}; pg8::StaticOrder S; S.init(M, DMODEL, G, bx); pg8::EpiOutRes E{F.x, F.out, H1B, F.ssq, ((PROBE_MASK >> 5) & 1) ? 0.5f : 1.0f, F.ssqa, EPS, {}, {}};
        pg8::gemm_phase<pg8::EpiOutRes, pg8::StaticOrder, PG8_ALIGN, PG8_SP2>(L, g, S, E); }
    SEAM(5);
    if (IN(6)) REP(6) { pg8::Gemm g{H1B, F.Wgu_t, M, NGU, DMODEL}; pg8::StaticOrder S; S.init(M, NGU, G, bx); pg8::EpiSwiGLU E{F.ssq, F.FF, EPS, {}, {}};
        pg8::gemm_phase<pg8::EpiSwiGLU, pg8::StaticOrder, PG8_ALIGN, PG8_SP2>(L, g, S, E); }
    SEAM(6);
    if (IN(7)) REP(7) { pg8::Gemm g{F.FF, F.Wd_t, M, DMODEL, D_FF}; pg8::StaticOrder S; S.init(M, DMODEL, G, bx); pg8::EpiAccum E{F.out, H1B};
        pg8::gemm_phase<pg8::EpiAccum, pg8::StaticOrder, PG8_ALIGN, PG8_SP2>(L, g, S, E); }
#undef IN
#undef SEAM
}

extern "C" void kernel_launch(void* const* d_in, const int* in_sizes, int n_in, void* d_out, int out_size, void* d_ws, size_t ws_size, hipStream_t stream) {
    static int grid = 0;
    if (grid == 0) {
        if (n_in != 19 || in_sizes[0] != M * DMODEL || out_size != M * DMODEL || ws_size < WS_END) { fprintf(stderr, "kernel_launch: unexpected shapes (n_in %d, in0 %d, out %d, ws %zu)\n", n_in, n_in > 0 ? in_sizes[0] : -1, out_size, ws_size); grid = -1; return; }
        int dev = 0, cus = 0, per_cu = 0;
        hipGetDevice(&dev); hipDeviceGetAttribute(&cus, hipDeviceAttributeMultiprocessorCount, dev);
        if (hipFuncSetAttribute((const void*)mk_fwd, hipFuncAttributeMaxDynamicSharedMemorySize, LDS_BYTES) != hipSuccess) { fprintf(stderr, "kernel_launch: hipFuncSetAttribute failed\n"); }
        if (hipOccupancyMaxActiveBlocksPerMultiprocessor(&per_cu, (const void*)mk_fwd, NWAVES * 64, LDS_BYTES) != hipSuccess || per_cu < 1) { fprintf(stderr, "kernel_launch: occupancy query says %d\n", per_cu); per_cu = 1; }
        (void)hipGetLastError();
        if (per_cu > 1) per_cu = 1;
        grid = cus * per_cu;
    }
    if (grid < 0) return;
    if (hipMemsetAsync((char*)d_ws + WS_CTL, 0, CTL_ZERO_BYTES, stream) != hipSuccess) { fprintf(stderr, "kernel_launch: memset failed\n"); return; }
    Args a{};
    for (int i = 0; i < 19; ++i) a.in[i] = (const float*)d_in[i];
    a.out = (float*)d_out; a.ws = (unsigned char*)d_ws;
#if MK_LAUNCHES == 1
    a.ph_lo = 0; a.ph_hi = NPHASE;
    void* kargs[] = {&a};
    hipError_t e = hipLaunchCooperativeKernel((const void*)mk_fwd, dim3(grid), dim3(NWAVES * 64), kargs, LDS_BYTES, stream);
    if (e != hipSuccess) fprintf(stderr, "kernel_launch: cooperative launch failed: %s (grid %d)\n", hipGetErrorString(e), grid);
#else
    for (int ph = 0; ph < NPHASE; ++ph) { a.ph_lo = ph; a.ph_hi = ph + 1; hipLaunchKernelGGL(mk_fwd, dim3(grid), dim3(NWAVES * 64), LDS_BYTES, stream, a); }
#endif
}
```
